# Optimizing an MI355X kernel written in HIP

```python
import math
import jax, jax.numpy as jnp
from jax import lax
import numpy as np

D_MODEL = 1024
BATCH = 32
SEQ = 256
DEPTH = 2
DEC_BATCH = 2
DEC_SEQ = 2048
PAST_LEN = 256

GRID_W = 64
H_A = 4
DQK_A = 64
DV_A = 128
W_A = H_A * DV_A
H_B = 4
DK_B = 64
DV_B = 64
W_B = H_B * DV_B
CHUNK = 64
H_C = 4
W_C = 256
BW_C = W_C // H_C
CONV_K = 4
CONV_PAD_L = 1
RG_C = 8.0
D_FF = 4 * D_MODEL
Q_BLOCK = 128
ROPE_BASE = 10000.0
EPS = 1e-6
SPLITS = (H_A * 2 * DQK_A, H_A * 2 * DQK_A, W_A,
          H_B * DK_B, H_B * DK_B, H_B * DK_B, W_B, W_B,
          W_C, W_C)
N_IN = sum(SPLITS)
F32 = jnp.float32

kernel_name = 'hybrid_diffattn_hgrn2_rglru_prefix_dit_step'


def _rms(x, g):
    xf = x.astype(F32)
    y = xf * lax.rsqrt(jnp.mean(xf * xf, axis=-1, keepdims=True) + EPS)
    return (y * g.astype(F32)).astype(x.dtype)


def _rev(a):
    return jnp.flip(a, axis=1)


def _rope_axis(x, pos):
    nf = x.shape[-1] // 2
    inv = ROPE_BASE ** (-jnp.arange(nf, dtype=F32) / nf)
    ang = pos.astype(F32)[:, None] * inv
    cos = jnp.cos(ang)[None, :, None, None, :]
    sin = jnp.sin(ang)[None, :, None, None, :]
    xf = x.astype(F32)
    x1, x2 = xf[..., :nf], xf[..., nf:]
    return jnp.concatenate([x1 * cos - x2 * sin, x1 * sin + x2 * cos], axis=-1).astype(x.dtype)


def _rope_2d(x):
    rows = x.shape[1] // GRID_W
    row = jnp.repeat(jnp.arange(rows), GRID_W)
    col = jnp.tile(jnp.arange(GRID_W), rows)
    half = x.shape[-1] // 2
    return jnp.concatenate([_rope_axis(x[..., :half], row), _rope_axis(x[..., half:], col)], axis=-1)


def _diff_attention(q, k, v, lam):
    B, Lq, H, _, Dk = q.shape
    nb = Lq // Q_BLOCK
    qb = q.reshape(B, nb, Q_BLOCK, H, 2, Dk).transpose(1, 0, 2, 3, 4, 5)
    scale = Dk ** -0.5

    def one_block(qblk):
        s = jnp.einsum('bqhmd,bkhmd->bhmqk', qblk, k).astype(F32) * scale
        p = jax.nn.softmax(s, axis=-1)
        w = p[:, :, 0] - lam * p[:, :, 1]
        return jnp.einsum('bhqk,bkhv->bqhv', w.astype(v.dtype), v)

    o = lax.map(one_block, qb)
    return o.transpose(1, 0, 2, 3, 4).reshape(B, Lq, H, v.shape[-1])


def _hgrn2_scan(q, k, v, logf, s0):
    B, L, H, Dk = q.shape
    Dv = v.shape[-1]
    n = L // CHUNK

    def chunks(a):
        return a.astype(F32).reshape(B, n, CHUNK, H, a.shape[-1]).transpose(1, 0, 3, 2, 4)

    causal = jnp.tril(jnp.ones((CHUNK, CHUNK), dtype=bool))[None, None, :, :, None]

    def step(s, inp):
        qc, kc, vc, gc = inp
        b = jnp.cumsum(gc, axis=2)
        rel = jnp.where(causal, b[:, :, :, None, :] - b[:, :, None, :, :], -jnp.inf)
        att = jnp.einsum('bhtd,bhsd,bhtsd->bhts', qc, kc, jnp.exp(rel))
        o = (jnp.einsum('bhts,bhsv->bhtv', att, vc)
             + jnp.einsum('bhtd,bhdv->bhtv', qc * jnp.exp(b), s))
        b_last = b[:, :, -1:, :]
        s_new = (jnp.exp(b_last[:, :, 0, :])[..., None] * s
                 + jnp.einsum('bhsd,bhsv->bhdv', kc * jnp.exp(b_last - b), vc))
        return s_new, o

    s_fin, o = lax.scan(step, s0.astype(F32), (chunks(q), chunks(k), chunks(v), chunks(logf)))
    return o.transpose(1, 0, 3, 2, 4).reshape(B, L, H, Dv), s_fin


def _lin_combine(left, right):
    a1, b1 = left
    a2, b2 = right
    return a1 * a2, a2 * b1 + b2


def _rglru_scan(x, w_r, b_r, w_i, b_i, lam, h0):
    B, L, _ = x.shape
    xb = x.reshape(B, L, H_C, BW_C)
    r = jax.nn.sigmoid(jnp.einsum('blhi,hij->blhj', xb, w_r.astype(F32)).reshape(B, L, W_C) + b_r.astype(F32))
    i = jax.nn.sigmoid(jnp.einsum('blhi,hij->blhj', xb, w_i.astype(F32)).reshape(B, L, W_C) + b_i.astype(F32))
    log_a = -RG_C * r * jax.nn.softplus(-lam.astype(F32))
    a = jnp.exp(log_a)
    u = jnp.sqrt(-jnp.expm1(2.0 * log_a)) * (i * x)
    u = u.at[:, 0].add(a[:, 0] * h0.astype(F32))
    _, h = lax.associative_scan(_lin_combine, (a, u), axis=1)
    return h, h[:, -1]


def _dwconv(x, w, b):
    L = x.shape[1]
    xp = jnp.pad(x, ((0, 0), (CONV_PAD_L, CONV_K - 1 - CONV_PAD_L), (0, 0)))
    y = b
    for j in range(CONV_K):
        y = y + xp[:, j:j + L] * w[j]
    return y


def _mixers(h, lp, lb, lam_init, ctx):
    B, L, _ = h.shape
    dt = h.dtype
    idx = np.cumsum(np.array(SPLITS))[:-1].tolist()
    q_a, k_a, v_a, q_b, ff_b, fb_b, i_b, g_b, x_c, g_c = jnp.split(h @ lp['w_in'], idx, axis=-1)

    q = _rms(q_a.reshape(B, L, H_A, 2, DQK_A), lp['qk_norm'][0])
    k = _rms(k_a.reshape(B, L, H_A, 2, DQK_A), lp['qk_norm'][1])
    v = v_a.reshape(B, L, H_A, DV_A)
    lv = lp['diff_lambda'].astype(F32)
    lam = jnp.exp(jnp.sum(lv[0] * lv[1])) - jnp.exp(jnp.sum(lv[2] * lv[3])) + lam_init
    if ctx is None:
        k_all, v_all = k, v
    else:
        q = _rope_2d(q)
        k_all = jnp.concatenate([_rope_2d(k), ctx[0].astype(dt)], axis=1)
        v_all = jnp.concatenate([v, ctx[1].astype(dt)], axis=1)
    o_a = _diff_attention(q, k_all, v_all, lam)
    o_a = (_rms(o_a, lp['subln']) * (1.0 - lam_init)).reshape(B, L, W_A)

    qh = jax.nn.silu(q_b).reshape(B, L, H_B, DK_B)
    ih = i_b.reshape(B, L, H_B, DV_B)

    def forget(fpre, lbd):
        fpre = fpre.astype(F32)
        logf = jnp.logaddexp(jnp.log(lbd), jnp.log1p(-lbd) + jax.nn.log_sigmoid(fpre))
        kk = (1.0 - lbd) * jax.nn.sigmoid(-fpre)
        return logf.reshape(B, L, H_B, DK_B), kk.reshape(B, L, H_B, DK_B)

    lf_f, k_f = forget(ff_b, lb[0])
    lf_b, k_b = forget(fb_b, lb[1])
    if ctx is None:
        s0f = jnp.zeros((B, H_B, DK_B, DV_B), F32)
        s0b = s0f
    else:
        s0f, s0b = ctx[2][:, 0], ctx[2][:, 1]
    o_f, s_f = _hgrn2_scan(qh, k_f, ih, lf_f, s0f)
    o_r, s_b = _hgrn2_scan(_rev(qh), _rev(k_b), _rev(ih), _rev(lf_b), s0b)
    o_b = (o_f + _rev(o_r)).astype(dt)
    o_b = (_rms(o_b, lp['hgrn_onorm']) * jax.nn.silu(g_b).reshape(B, L, H_B, DV_B)).reshape(B, L, W_B)

    xc = _dwconv(x_c, lp['conv_w'], lp['conv_b']).astype(F32)
    if ctx is None:
        h0f = jnp.zeros((B, W_C), F32)
        h0b = h0f
    else:
        h0f, h0b = ctx[3][:, 0], ctx[3][:, 1]
    rw, rb, rl = lp['rg_w'], lp['rg_b'], lp['rg_lambda']
    y_f, hf = _rglru_scan(xc, rw[0, 0], rb[0, 0], rw[0, 1], rb[0, 1], rl[0], h0f)
    y_r, hb = _rglru_scan(_rev(xc), rw[1, 0], rb[1, 0], rw[1, 1], rb[1, 1], rl[1], h0b)
    o_c = (y_f + _rev(y_r)).astype(dt) * jax.nn.gelu(g_c)

    out = jnp.concatenate([o_a, o_b, o_c], axis=-1) @ lp['w_out']
    if ctx is None:
        new_ctx = (k, v, jnp.stack([s_f, s_b], axis=1).astype(dt), jnp.stack([hf, hb], axis=1).astype(dt))
    else:
        new_ctx = None
    return out, new_ctx


def _block(x, mod, lp, lb, lam_init, ctx):
    sh1, sc1, g1, sh2, sc2, g2 = jnp.split(mod[:, None, :], 6, axis=-1)
    h = _rms(x, lp['norm1']) * (1 + sc1) + sh1
    mix, new_ctx = _mixers(h, lp, lb, lam_init, ctx)
    x = x + g1 * mix
    h = _rms(x, lp['norm2']) * (1 + sc2) + sh2
    x = x + g2 * (jnp.square(jax.nn.relu(h @ lp['w_ff1'])) @ lp['w_ff2'])
    return x, new_ctx


def setup_inputs(seed: int = 0) -> dict:
    key = jax.random.key(seed)
    ks = jax.random.split(key, 26)
    D = D_MODEL

    def nrm(k, shape, s):
        return jax.random.normal(k, shape, F32) * s

    u = jax.random.uniform(ks[25], (DEPTH, 2, W_C), F32, 0.9, 0.999)
    a_base = u ** (1.0 / RG_C)
    rg_lambda = jnp.log(a_base) - jnp.log1p(-a_base)
    return {
        'x_prompt': nrm(ks[0], (BATCH, SEQ, D), 1.0),
        'x_sample': nrm(ks[1], (DEC_BATCH, DEC_SEQ, D), 1.0),
        'cache_k': nrm(ks[2], (DEC_BATCH, DEPTH, PAST_LEN, H_A, 2, DQK_A), 1.0),
        'cache_v': nrm(ks[3], (DEC_BATCH, DEPTH, PAST_LEN, H_A, DV_A), 1.0),
        'state_hgrn': nrm(ks[4], (DEC_BATCH, DEPTH, 2, H_B, DK_B, DV_B), 0.5),
        'state_rglru': nrm(ks[5], (DEC_BATCH, DEPTH, 2, W_C), 0.5),
        'c': nrm(ks[6], (DEC_BATCH, D), 1.0),
        'c_ctx': nrm(ks[7], (D,), 1.0),
        'w_mod': nrm(ks[8], (DEPTH, D, 6 * D), 0.5 * D ** -0.5),
        'b_mod': nrm(ks[9], (DEPTH, 6 * D), 0.02),
        'norm1': 1.0 + nrm(ks[10], (DEPTH, D), 0.02),
        'norm2': 1.0 + nrm(ks[11], (DEPTH, D), 0.02),
        'w_in': nrm(ks[12], (DEPTH, D, N_IN), D ** -0.5),
        'w_out': nrm(ks[13], (DEPTH, D, D), D ** -0.5),
        'qk_norm': 1.0 + nrm(ks[14], (DEPTH, 2, DQK_A), 0.02),
        'diff_lambda': nrm(ks[15], (DEPTH, 4, DQK_A), 0.1),
        'subln': 1.0 + nrm(ks[16], (DEPTH, DV_A), 0.02),
        'hgrn_lb': nrm(ks[17], (DEPTH, 2, H_B * DK_B), 0.1),
        'hgrn_onorm': 1.0 + nrm(ks[18], (DEPTH, DV_B), 0.02),
        'conv_w': nrm(ks[19], (DEPTH, CONV_K, W_C), CONV_K ** -0.5),
        'conv_b': nrm(ks[20], (DEPTH, W_C), 0.02),
        'rg_w': nrm(ks[21], (DEPTH, 2, 2, H_C, BW_C, BW_C), BW_C ** -0.5),
        'rg_b': nrm(ks[22], (DEPTH, 2, 2, W_C), 0.02),
        'rg_lambda': rg_lambda,
        'w_ff1': nrm(ks[23], (DEPTH, D, D_FF), D ** -0.5),
        'w_ff2': nrm(ks[24], (DEPTH, D_FF, D), D_FF ** -0.5),
    }


def reference(x_prompt, x_sample, cache_k, cache_v, state_hgrn, state_rglru, c, c_ctx,
              w_mod, b_mod, norm1, norm2, w_in, w_out, qk_norm, diff_lambda, subln,
              hgrn_lb, hgrn_onorm, conv_w, conv_b, rg_w, rg_b, rg_lambda, w_ff1, w_ff2):
    lb_all = jnp.cumsum(jax.nn.softmax(hgrn_lb.astype(F32), axis=0), axis=0)
    yp, ys = x_prompt, x_sample
    ks, vs, shs, srs = [], [], [], []
    for l in range(DEPTH):
        lp = {'norm1': norm1[l], 'norm2': norm2[l], 'w_in': w_in[l], 'w_out': w_out[l],
              'qk_norm': qk_norm[l], 'diff_lambda': diff_lambda[l], 'subln': subln[l],
              'hgrn_onorm': hgrn_onorm[l], 'conv_w': conv_w[l], 'conv_b': conv_b[l],
              'rg_w': rg_w[l], 'rg_b': rg_b[l], 'rg_lambda': rg_lambda[l],
              'w_ff1': w_ff1[l], 'w_ff2': w_ff2[l]}
        lb = lb_all[l] - lb_all[0]
        lam_init = 0.8 - 0.6 * math.exp(-0.3 * l)
        mod_ctx = (jax.nn.silu(c_ctx) @ w_mod[l] + b_mod[l])[None]
        mod_lat = jax.nn.silu(c) @ w_mod[l] + b_mod[l]
        yp, (k_l, v_l, sh_l, sr_l) = _block(yp, mod_ctx, lp, lb, lam_init, None)
        ys, _ = _block(ys, mod_lat, lp, lb, lam_init,
                       (cache_k[:, l], cache_v[:, l], state_hgrn[:, l], state_rglru[:, l]))
        ks.append(k_l)
        vs.append(v_l)
        shs.append(sh_l)
        srs.append(sr_l)
    return (yp, ys, jnp.stack(ks, axis=1), jnp.stack(vs, axis=1), jnp.stack(shs, axis=1), jnp.stack(srs, axis=1))
```

```cpp
#include <hip/hip_runtime.h>
#include <hip/hip_cooperative_groups.h>
#include <cstdio>
#include <cstdint>
namespace cg = cooperative_groups;
#ifndef MK_COOP
#define MK_COOP 1
#endif
#ifndef DIS_PREP
#define DIS_PREP 0
#endif
#ifndef DIS_RGL
#define DIS_RGL 0
#endif
#ifndef DIS_HGRN
#define DIS_HGRN 0
#endif
#ifndef DIS_ATTN
#define DIS_ATTN 0
#endif
#ifndef DIS_FIX
#define DIS_FIX 0
#endif
#ifndef REP_SP
#define REP_SP (-1)
#endif
#ifndef EXTRA_SYNCS
#define EXTRA_SYNCS 0
#endif
#define P0_ITEMS (I_IN + I_OUT)
#define FILL_FIRST(l) ((l) == 0 ? P0_ITEMS : I_L + I_IN + I_OUT)
#define FILL_END(l) ((l) == 0 ? I_L + I_IN + I_OUT : 2 * I_L)
#define NFILL(l) ((FILL_END(l) - FILL_FIRST(l) + 7) / 8)
#ifndef NPASS
#define NPASS 1
#endif
#ifndef REP_ONLY
#define REP_ONLY 0
#endif
#ifndef STATIC_Q
#define STATIC_Q 0
#endif
#ifndef CG_SYNC_PHASE
#define CG_SYNC_PHASE 1000
#endif
#ifndef PRE_K
#define PRE_K 0
#endif
#ifndef BAL_PMA
#define BAL_PMA 0
#endif
#ifndef FAKE_ST
#define FAKE_ST 0
#endif
#ifndef SKIP_T
#define SKIP_T 0
#endif
#ifndef X1_BF16
#define X1_BF16 1
#endif
namespace pg8 {
#define PG8_LAS __attribute__((address_space(3)))
typedef unsigned short bf16_t;
typedef short bf16x8 __attribute__((ext_vector_type(8)));
typedef float f32x4 __attribute__((ext_vector_type(4)));
typedef unsigned u32x4 __attribute__((ext_vector_type(4)));
constexpr int BM = 256, BK = 64, HALF = 128, HTB = HALF * BK * 2  , STAGE_BYTES = 8 * HTB, NXCD = 8, WGM = 8;

__host__ __device__ __forceinline__ int lds_byte(int r, int c) { const int st = (r >> 4) * 2 + (c >> 5), rr = r & 15, cc = c & 31, ob = rr * 64 + cc * 2; return st * 1024 + (ob ^ (((ob >> 9) & 1) << 5)); }
__host__ __device__ __forceinline__ void stage_rc(int b, int& R, int& C) { const int st = b / 1024, sb = b % 1024, swz = sb ^ (((sb >> 9) & 1) << 5); R = (st >> 1) * 16 + swz / 64; C = (st & 1) * 32 + (swz % 64) / 2; }
__host__ __device__ __forceinline__ int perm32(int rho) { const int n = rho >> 4, i = rho & 15; return 8 * (i >> 2) + 4 * n + (i & 3); }

struct Unit { int pm, pn; };
struct Gemm { const bf16_t* A; const bf16_t* Bt; int M, N, K; };

struct StaticOrder {
    int nM, nN, nwg, G, c;
    __host__ __device__ void init(int M, int N, int G_, int c_) { nM = M / BM; nN = N / BM; nwg = nM * nN; G = G_; c = c_; }
    __host__ __device__ bool next(int i, Unit& u) const {
        const long L = (long)i * G + c; if (L >= nwg) return false;
        int wgid = (int)L; { const int q = nwg / NXCD, r = nwg % NXCD, xcd = wgid % NXCD, off = wgid / NXCD; wgid = (xcd < r ? xcd * (q + 1) : r * (q + 1) + (xcd - r) * q) + off; }
        const int nig = WGM * nN, gid = wgid / nig, fm = gid * WGM, gsz = (nM - fm) < WGM ? (nM - fm) : WGM;
        u.pm = fm + ((wgid % nig) % gsz); u.pn = (wgid % nig) / gsz; return true;
    }
    __device__ __forceinline__ void a_ready(const Unit&) const {}
    __device__ __forceinline__ void done(const Unit&) const {}
};

__device__ __forceinline__ unsigned cvt_pk_bf16(float lo, float hi) { unsigned r; asm volatile("v_cvt_pk_bf16_f32 %0, %1, %2" : "=v"(r) : "v"(lo), "v"(hi)); return r; }
typedef float f32x2 __attribute__((ext_vector_type(2)));
__device__ __forceinline__ f32x2 gelu_pk(f32x2 v) {
    const f32x2 av = __builtin_elementwise_abs(v), d = av * 0.2316418882f + 1.0f;
    f32x2 t; t.x = __builtin_amdgcn_rcpf(d.x); t.y = __builtin_amdgcn_rcpf(d.y);
    f32x2 q = t * 0.5307027145f + (-0.7265760135f); q = q * t + 0.7107068705f; q = q * t + (-0.142248368f); q = q * t + 0.127414796f; q = q * t;
    const f32x2 s = (v * v) * (-0.72134752044f);
    f32x2 e; e.x = __builtin_amdgcn_exp2f(s.x); e.y = __builtin_amdgcn_exp2f(s.y);
    const f32x2 m = v * (q * e), r = v - m;
    f32x2 o; o.x = v.x < 0.f ? m.x : r.x; o.y = v.y < 0.f ? m.y : r.y; return o;
}

template <int ACT  > struct EpiBf16 {
    static constexpr bool PERM = true, AFTER_DRAIN = false; static_assert(ACT >= 0 && ACT <= 2, "EpiBf16: ACT is 0 (none), 1 (gelu_pk) or 2 (relu squared)");
    bf16_t* O; int ldc; const float* bias; int split_cols; size_t split_stride; float scale0; const float* rowss; int bias_rstride;
    __device__ __forceinline__ void operator()(const f32x4 (&acc)[2][2][4][2], const Unit& u, int wr, int wc, int fr, int fq) const {
        const int row0 = u.pm * BM + wr * 64 + fr; int colt = u.pn * BM; bf16_t* base = O;
        float sc = 1.f; if (split_cols) { const int t = colt / split_cols; base += (size_t)t * split_stride; colt -= t * split_cols; if (t == 0) sc = scale0; }
        const int col0 = colt + wc * 32 + 8 * fq, bcol0 = u.pn * BM + wc * 32 + 8 * fq;
        f32x4 bv[2][2]; const float* biasr = bias ? bias + (size_t)(u.pm < 32 ? 0 : 1 + ((u.pm - 32) >> 3)) * bias_rstride : nullptr;
#pragma unroll
        for (int bj = 0; bj < 2; ++bj)
#pragma unroll
            for (int n = 0; n < 2; ++n) bv[bj][n] = biasr ? *(const f32x4*)(biasr + bcol0 + bj * HALF + 4 * n) : (f32x4){0.f, 0.f, 0.f, 0.f};
#pragma unroll
        for (int ai = 0; ai < 2; ++ai)
#pragma unroll
            for (int m = 0; m < 4; ++m) { bf16_t* rowp = base + (size_t)(row0 + ai * HALF + m * 16) * ldc + col0;
                float rs = 1.f; if (rowss) { const f32x4* rp = (const f32x4*)(rowss + (size_t)(row0 + ai * HALF + m * 16) * 16); const f32x4 s4 = (rp[0] + rp[1]) + (rp[2] + rp[3]); rs = __builtin_amdgcn_rsqf(((s4[0] + s4[1]) + (s4[2] + s4[3])) * (1.f / 1024.f) + 1e-6f); }
#pragma unroll
                for (int bj = 0; bj < 2; ++bj) { f32x4 v0 = acc[ai][bj][m][0] * rs + bv[bj][0], v1 = acc[ai][bj][m][1] * rs + bv[bj][1];
                    if (ACT == 1) { f32x2 a = gelu_pk((f32x2){v0[0], v0[1]}), b = gelu_pk((f32x2){v0[2], v0[3]}), c = gelu_pk((f32x2){v1[0], v1[1]}), d = gelu_pk((f32x2){v1[2], v1[3]});
                        v0 = (f32x4){a.x, a.y, b.x, b.y}; v1 = (f32x4){c.x, c.y, d.x, d.y}; }
                    if (ACT == 2) { v0 = __builtin_elementwise_max(v0, (f32x4){0.f, 0.f, 0.f, 0.f}); v1 = __builtin_elementwise_max(v1, (f32x4){0.f, 0.f, 0.f, 0.f}); v0 = v0 * v0; v1 = v1 * v1; }
                    v0 = v0 * sc; v1 = v1 * sc; u32x4 w; w.x = cvt_pk_bf16(v0[0], v0[1]); w.y = cvt_pk_bf16(v0[2], v0[3]); w.z = cvt_pk_bf16(v1[0], v1[1]); w.w = cvt_pk_bf16(v1[2], v1[3]);
                    *(u32x4*)(rowp + bj * HALF) = w; } }
    }
};

typedef unsigned u32x2v __attribute__((ext_vector_type(2)));

struct EpiResGate {
    static constexpr bool PERM = true, AFTER_DRAIN = false;
    const float* xinP; const float* xinS; float* xout; const float* modl; int gate_off;
    const float* nwn; const float* scn; bf16_t* An; float* rowss;
    bf16_t* xout16; const bf16_t* xin16;
    __device__ __forceinline__ void operator()(const f32x4 (&acc)[2][2][4][2], const Unit& u, int wr, int wc, int fr, int fq) const {
        const int rmod = u.pm < 32 ? 0 : 1 + ((u.pm - 32) >> 3);
        const float* g = modl + rmod * 6144 + gate_off; const float* xin = u.pm < 32 ? xinP : xinS;
        const int col0 = u.pn * BM + wc * 32 + 8 * fq;
        f32x4 gv[2][2], gs[2][2];
#pragma unroll
        for (int bj = 0; bj < 2; ++bj)
#pragma unroll
            for (int n = 0; n < 2; ++n) { gv[bj][n] = *(const f32x4*)(g + col0 + bj * HALF + n * 4);
                gs[bj][n] = nwn ? *(const f32x4*)(nwn + col0 + bj * HALF + n * 4) * (*(const f32x4*)(scn + rmod * 6144 + col0 + bj * HALF + n * 4) + 1.f) : (f32x4){0.f, 0.f, 0.f, 0.f}; }
#pragma unroll
        for (int ai = 0; ai < 2; ++ai)
#pragma unroll
            for (int m = 0; m < 4; ++m) { const int row = u.pm * BM + ai * HALF + wr * 64 + m * 16 + fr; const size_t off = (size_t)row * 1024 + col0;
                float ss = 0.f; u32x4 aw[2], xw[2];
#pragma unroll
                for (int bj = 0; bj < 2; ++bj)
#pragma unroll
                    for (int n = 0; n < 2; ++n) { f32x4 xv;
                        if (xin16) { const u32x2v w_ = *(const u32x2v*)(xin16 + off + bj * HALF + n * 4); xv = (f32x4){__uint_as_float(w_.x << 16), __uint_as_float(w_.x & 0xffff0000u), __uint_as_float(w_.y << 16), __uint_as_float(w_.y & 0xffff0000u)}; }
                        else xv = *(const f32x4*)(xin + off + bj * HALF + n * 4);
                        const f32x4 xo = xv + gv[bj][n] * acc[ai][bj][m][n];
                        if (xout16) { xw[bj][2 * n] = cvt_pk_bf16(xo[0], xo[1]); xw[bj][2 * n + 1] = cvt_pk_bf16(xo[2], xo[3]); }
                        else if (!nwn) __builtin_nontemporal_store(xo, (f32x4*)(xout + off + bj * HALF + n * 4));
                        else *(f32x4*)(xout + off + bj * HALF + n * 4) = xo;
                        if (nwn) { ss += (xo[0] * xo[0] + xo[1] * xo[1]) + (xo[2] * xo[2] + xo[3] * xo[3]); const f32x4 av = xo * gs[bj][n];
                            aw[bj][2 * n] = cvt_pk_bf16(av[0], av[1]); aw[bj][2 * n + 1] = cvt_pk_bf16(av[2], av[3]); } }
                if (nwn) {
#pragma unroll
                    for (int bj = 0; bj < 2; ++bj) *(u32x4*)(An + off + bj * HALF) = aw[bj]; }
                if (xout16) {
#pragma unroll
                    for (int bj = 0; bj < 2; ++bj) *(u32x4*)(xout16 + off + bj * HALF) = xw[bj]; }
                if (nwn) { ss += __shfl_xor(ss, 16); ss += __shfl_xor(ss, 32); if (fq == 0) rowss[(size_t)row * 16 + u.pn * 4 + wc] = ss; } }
    }
};
template <class Epi, class Sched, bool ALIGN_EPI = false, bool SP2 = false>
__device__ __forceinline__ void gemm_phase(PG8_LAS unsigned char* lds, const Gemm g, const Sched& S, const Epi& E) {
    int tid_ = threadIdx.x; asm volatile("" : "+v"(tid_)); const int tid = tid_, wid = __builtin_amdgcn_readfirstlane(tid >> 6), lane = tid & 63, wr = wid >> 2, wc = wid & 3, fr = lane & 15, fq = lane >> 4;
    const int K = g.K, nt = K / BK;
    unsigned voffA[2], voffB[2];
#pragma unroll
    for (int i = 0; i < 2; ++i) { int R, C; stage_rc(tid * 16 + i * 8192, R, C); const int Rb = Epi::PERM ? ((R & ~31) + perm32(R & 31)) : R;
        voffA[i] = (unsigned)(R * K + C) * 2u; voffB[i] = (unsigned)(Rb * K + C) * 2u; }
    const size_t kstep = (size_t)(BK * 2);
    const size_t hstep = (size_t)HALF * K * 2;
    const size_t tstep = 2 * hstep;
    const unsigned ldsw = (unsigned)wid * 1024u;
    const int aoff = lds_byte(wr * 64 + fr, fq * 8), boff = lds_byte(wc * 32 + fr, fq * 8);
#define PG8_SA(b, h) (((b) * 2 + (h)) * HTB)
#define PG8_SB(b, h) ((4 + (b) * 2 + (h)) * HTB)
#define PG8_STAGE(bufoff, gbase, voff) do { _Pragma("unroll") for (int _i = 0; _i < 2; ++_i) \
        __builtin_amdgcn_global_load_lds((const unsigned*)((const char*)(gbase) + (voff)[_i]), (PG8_LAS unsigned*)(lds + (bufoff) + ldsw + _i * 8192), 16, 0, 0); } while (0)
#define PG8_LDA(dst, b, h) do { _Pragma("unroll") for (int m = 0; m < 4; ++m) _Pragma("unroll") for (int k = 0; k < 2; ++k) dst[m][k] = *(const PG8_LAS bf16x8*)(lds + PG8_SA(b, h) + aoff + m * 2048 + k * 1024); } while (0)
#define PG8_LDB(dst, b, h) do { _Pragma("unroll") for (int n = 0; n < 2; ++n) _Pragma("unroll") for (int k = 0; k < 2; ++k) dst[n][k] = *(const PG8_LAS bf16x8*)(lds + PG8_SB(b, h) + boff + n * 2048 + k * 1024); } while (0)
#define PG8_MMA(ai, bj, At, Bt) do { __builtin_amdgcn_s_setprio(1); _Pragma("unroll") for (int m = 0; m < 4; ++m) _Pragma("unroll") for (int n = 0; n < 2; ++n) _Pragma("unroll") for (int k = 0; k < 2; ++k) \
        acc[ai][bj][m][n] = __builtin_amdgcn_mfma_f32_16x16x32_bf16(Bt[n][k], At[m][k], acc[ai][bj][m][n], 0, 0, 0); __builtin_amdgcn_s_setprio(0); } while (0)
#define PG8_WAIT_V(n) asm volatile("s_waitcnt vmcnt(" #n ")" ::: "memory")
#define PG8_WAIT_L(n) asm volatile("s_waitcnt lgkmcnt(" #n ")" ::: "memory")
#define PG8_BAR __builtin_amdgcn_s_barrier()
#define PG8_SCHED __builtin_amdgcn_sched_barrier(0)
    Unit cur, nxt; int ui = 0;
    if (!S.next(0, cur)) return;
    f32x4 acc[2][2][4][2];
#pragma unroll
    for (int a = 0; a < 2; ++a)
#pragma unroll
        for (int b = 0; b < 2; ++b)
#pragma unroll
            for (int m = 0; m < 4; ++m)
#pragma unroll
                for (int n = 0; n < 2; ++n) acc[a][b][m][n] = (f32x4){0.f, 0.f, 0.f, 0.f};
    bf16x8 At[4][2], B0[2][2], B1[2][2];
    const char* cA = (const char*)g.A + (size_t)cur.pm * tstep; const char* cB = (const char*)g.Bt + (size_t)cur.pn * tstep;
    S.a_ready(cur);
    if constexpr (SP2) {
        PG8_STAGE(PG8_SB(0, 0), cB, voffB); PG8_STAGE(PG8_SB(0, 1), cB + hstep, voffB); PG8_STAGE(PG8_SA(0, 0), cA, voffA); PG8_STAGE(PG8_SA(0, 1), cA + hstep, voffA);
        if (wr == 1) PG8_BAR;
        PG8_WAIT_V(2); PG8_BAR;
        PG8_STAGE(PG8_SB(1, 0), cB + kstep, voffB); PG8_STAGE(PG8_SA(1, 0), cA + kstep, voffA); PG8_STAGE(PG8_SB(1, 1), cB + hstep + kstep, voffB);
        PG8_WAIT_V(6); PG8_BAR;
    } else {
        PG8_STAGE(PG8_SB(0, 0), cB, voffB); PG8_STAGE(PG8_SA(0, 0), cA, voffA); PG8_STAGE(PG8_SB(0, 1), cB + hstep, voffB); PG8_STAGE(PG8_SA(0, 1), cA + hstep, voffA);
        if (wr == 1) PG8_BAR;
        PG8_WAIT_V(4); PG8_BAR;
        PG8_STAGE(PG8_SB(1, 0), cB + kstep, voffB); PG8_STAGE(PG8_SA(1, 0), cA + kstep, voffA); PG8_STAGE(PG8_SB(1, 1), cB + hstep + kstep, voffB);
        PG8_WAIT_V(6); PG8_BAR;
    }
    for (;;) {
        const bool has_next = S.next(ui + 1, nxt);
        const char* nA = has_next ? (const char*)g.A + (size_t)nxt.pm * tstep : cA; const char* nB = has_next ? (const char*)g.Bt + (size_t)nxt.pn * tstep : cB;
        for (int t = 0; t < nt; t += 2) {
            const bool last = (t == nt - 2);
            const char* a1 = cA + (size_t)(t + 1) * kstep;
            const char* a2 = last ? nA : cA + (size_t)(t + 2) * kstep; const char* b2 = last ? nB : cB + (size_t)(t + 2) * kstep;
            const char* a3 = a2 + kstep; const char* b3 = b2 + kstep;
            if (last && has_next) S.a_ready(nxt);
            if constexpr (SP2) {
            PG8_LDB(B0, 0, 0); PG8_LDB(B1, 0, 1); PG8_SCHED; PG8_LDA(At, 0, 0); PG8_STAGE(PG8_SA(1, 1), a1 + hstep, voffA);
            PG8_WAIT_V(8); PG8_WAIT_L(0); PG8_BAR; PG8_MMA(0, 0, At, B0); PG8_MMA(0, 1, At, B1); PG8_BAR; PG8_SCHED;
            PG8_LDA(At, 0, 1); PG8_STAGE(PG8_SB(0, 0), b2, voffB); PG8_STAGE(PG8_SB(0, 1), b2 + hstep, voffB); PG8_STAGE(PG8_SA(0, 0), a2, voffA);
            PG8_WAIT_V(8); PG8_WAIT_L(0); PG8_BAR; PG8_MMA(1, 0, At, B0); PG8_MMA(1, 1, At, B1); PG8_BAR; PG8_SCHED;
            PG8_LDB(B0, 1, 0); PG8_LDB(B1, 1, 1); PG8_SCHED; PG8_LDA(At, 1, 0); PG8_STAGE(PG8_SA(0, 1), a2 + hstep, voffA);
            PG8_WAIT_V(8); PG8_WAIT_L(0); PG8_BAR; PG8_MMA(0, 0, At, B0); PG8_MMA(0, 1, At, B1); PG8_BAR; PG8_SCHED;
            PG8_LDA(At, 1, 1); PG8_STAGE(PG8_SB(1, 0), b3, voffB); PG8_STAGE(PG8_SB(1, 1), b3 + hstep, voffB); PG8_STAGE(PG8_SA(1, 0), a3, voffA);
            PG8_WAIT_V(8); PG8_WAIT_L(0); PG8_BAR; PG8_MMA(1, 0, At, B0); PG8_MMA(1, 1, At, B1); PG8_BAR; PG8_SCHED;
            } else {
            PG8_LDB(B0, 0, 0); PG8_SCHED; PG8_LDA(At, 0, 0); PG8_STAGE(PG8_SA(1, 1), a1 + hstep, voffA);
            PG8_WAIT_L(8); PG8_BAR; PG8_WAIT_L(0); PG8_MMA(0, 0, At, B0); PG8_BAR; PG8_SCHED;
            PG8_LDB(B1, 0, 1); PG8_STAGE(PG8_SB(0, 0), b2, voffB);
            PG8_BAR; PG8_WAIT_L(0); PG8_MMA(0, 1, At, B1); PG8_BAR;
            PG8_LDA(At, 0, 1); PG8_STAGE(PG8_SA(0, 0), a2, voffA);
            PG8_BAR; PG8_WAIT_L(0); PG8_MMA(1, 0, At, B0); PG8_BAR; PG8_SCHED;
            PG8_STAGE(PG8_SB(0, 1), b2 + hstep, voffB);
            PG8_WAIT_V(6); PG8_BAR; PG8_MMA(1, 1, At, B1); PG8_BAR;
            PG8_LDB(B0, 1, 0); PG8_SCHED; PG8_LDA(At, 1, 0); PG8_STAGE(PG8_SA(0, 1), a2 + hstep, voffA);
            PG8_WAIT_L(8); PG8_BAR; PG8_WAIT_L(0); PG8_MMA(0, 0, At, B0); PG8_BAR; PG8_SCHED;
            PG8_LDB(B1, 1, 1); PG8_STAGE(PG8_SB(1, 0), b3, voffB);
            PG8_BAR; PG8_WAIT_L(0); PG8_MMA(0, 1, At, B1); PG8_BAR;
            PG8_LDA(At, 1, 1); PG8_STAGE(PG8_SA(1, 0), a3, voffA);
            PG8_BAR; PG8_WAIT_L(0); PG8_MMA(1, 0, At, B0); PG8_BAR; PG8_SCHED;
            PG8_STAGE(PG8_SB(1, 1), b3 + hstep, voffB);
            PG8_WAIT_V(6); PG8_BAR; PG8_MMA(1, 1, At, B1); PG8_BAR;
            }
        }
        if constexpr (ALIGN_EPI) { if (wr == 0) PG8_BAR; }
        if constexpr (!Epi::AFTER_DRAIN) { E(acc, cur, wr, wc, fr, fq); S.done(cur); }
        if (!has_next) break;
#pragma unroll
        for (int a = 0; a < 2; ++a)
#pragma unroll
            for (int b = 0; b < 2; ++b)
#pragma unroll
                for (int m = 0; m < 4; ++m)
#pragma unroll
                    for (int n = 0; n < 2; ++n) acc[a][b][m][n] = (f32x4){0.f, 0.f, 0.f, 0.f};
        cur = nxt; cA = nA; cB = nB; ++ui;
        if constexpr (ALIGN_EPI) { if (wr == 1) PG8_BAR; }
    }
    PG8_WAIT_V(0);
    if constexpr (!ALIGN_EPI) { if (wr == 0) PG8_BAR; }
    PG8_BAR;
    if constexpr (Epi::AFTER_DRAIN) { E.fused(acc, cur, wr, wc, fr, fq, lds, wid, lane); S.done(cur); }
#undef PG8_SA
#undef PG8_SB
#undef PG8_STAGE
#undef PG8_LDA
#undef PG8_LDB
#undef PG8_MMA
#undef PG8_WAIT_V
#undef PG8_WAIT_L
#undef PG8_BAR
#undef PG8_SCHED
}
}

#define LAS __attribute__((address_space(3)))
#define DI __device__ __forceinline__
typedef unsigned short bf16_t;
typedef unsigned char uchar;
typedef short bf16x8 __attribute__((ext_vector_type(8)));
typedef short s16x4 __attribute__((ext_vector_type(4)));
typedef float f32x4 __attribute__((ext_vector_type(4)));
typedef float f32x2 __attribute__((ext_vector_type(2)));
typedef float f32x16 __attribute__((ext_vector_type(16)));
typedef unsigned u32x4 __attribute__((ext_vector_type(4)));
typedef unsigned u32x2 __attribute__((ext_vector_type(2)));
typedef __bf16 bf16x2_t __attribute__((ext_vector_type(2)));

constexpr int DM = 1024, MP = 8192, MS = 4096, MT = 12288, NIN = 3328, DFF = 4096;
constexpr int C_QA = 0, C_KA = 512, C_VA = 1024, C_QB = 1536, C_FF = 1792, C_FB = 2048, C_IB = 2304, C_GB = 2560, C_XC = 2816, C_GC = 3072;
constexpr float EPS = 1e-6f;
constexpr size_t MiB = 1u << 20;
constexpr size_t WS_CTL = 0, CTL_BYTES = 1 * MiB, WS_MOD = 65536;
constexpr size_t WS_RS = 252 * MiB, WS_SHW = 704 * 1024;
constexpr size_t WS_SUM = 1 * MiB;
constexpr size_t WS_KC = 2 * MiB, WS_VC = 2 * MiB + 512 * 1024;
constexpr size_t WS_WT = 4 * MiB;
constexpr size_t WT_IN = 0, WT_OUT = (size_t)NIN * DM * 2, WT_1 = WT_OUT + (size_t)DM * DM * 2, WT_2 = WT_1 + (size_t)DFF * DM * 2, WT_LAYER = WT_2 + (size_t)DM * DFF * 2;
constexpr size_t WS_AH = 54 * MiB;
constexpr size_t WS_YIN = 78 * MiB;
constexpr size_t WS_SIN = 156 * MiB;
constexpr size_t WS_LL = 228 * MiB;
constexpr size_t WS_HO = 54 * MiB, WS_DD = 66 * MiB;
constexpr size_t WS_AMIX = 180 * MiB;
constexpr size_t WS_HL = 204 * MiB, WS_PC = 216 * MiB;
constexpr size_t WS_HFF = 78 * MiB;
constexpr size_t WS_END = 255 * MiB;
static_assert(WS_WT + 2 * WT_LAYER <= WS_AH && WS_HFF + (size_t)MT * DFF * 2 <= WS_AMIX, "ws map");
constexpr int RING_BYTES = 131072, LDS_BYTES = 155648;
constexpr int NPHASE = 19;
constexpr int CW_Q = 65536;
constexpr int CW_BAR = 4096;

struct KArgs {
    const float* in[26]; float* out; uchar* ws; int ph_lo, ph_hi;
};
typedef const __attribute__((address_space(4))) KArgs* KAP;
enum { I_XP = 0, I_XS, I_CK, I_CV, I_SH, I_SR, I_C, I_CCTX, I_WMOD, I_BMOD, I_N1, I_N2, I_WIN, I_WOUT, I_QKN, I_DLAM, I_SUBLN, I_HLB, I_HON, I_CW, I_CB, I_RGW, I_RGB, I_RGL, I_W1, I_W2 };
constexpr size_t O_YP = 0, O_YS = 8388608, O_CK = 12582912, O_CV = 20971520, O_SH = 29360128, O_SR = 31457280;

DI float bf2f(unsigned short b) { return __uint_as_float((unsigned)b << 16); }
DI unsigned pk2(float lo, float hi) { f32x2 v = {lo, hi}; bf16x2_t b = __builtin_convertvector(v, bf16x2_t); return __builtin_bit_cast(unsigned, b); }
DI unsigned short f2bf(float f) { return (unsigned short)(pk2(f, 0.f) & 0xffffu); }
DI void unpack8(const u32x4 w, float* x) {
#pragma unroll
    for (int i = 0; i < 4; ++i) { x[2 * i] = __uint_as_float(w[i] << 16); x[2 * i + 1] = __uint_as_float(w[i] & 0xffff0000u); }
}
DI float sigmoidf_(float x) { return __builtin_amdgcn_rcpf(1.f + __expf(-x)); }
DI float siluf_(float x) { return x * __builtin_amdgcn_rcpf(1.f + __expf(-x)); }
DI float gelu_tanh(float x) { const float y = 0.7978845608028654f * (x + 0.044715f * x * x * x); const float t = 1.f - 2.f * __builtin_amdgcn_rcpf(1.f + __expf(2.f * y)); return 0.5f * x * (1.f + t); }
DI float wave_sum(float v) {
#pragma unroll
    for (int o = 1; o < 64; o <<= 1) v += __shfl_xor(v, o);
    return v;
}
DI int crow(int reg, int h) { return (reg & 3) + 8 * (reg >> 2) + 4 * h; }
#define MFMA32(a, b, c) __builtin_amdgcn_mfma_f32_32x32x16_bf16((a), (b), (c), 0, 0, 0)

DI void p0_transpose_item(const float* W, int K, int N, bf16_t* WT, LAS float* scr, int item, int lane) {
    const int nblk = N / 32, kb = item / nblk, nb = item % nblk, k0 = 64 * kb, n0 = 32 * nb;
    float wv_[32];
#pragma unroll
    for (int i = 0; i < 32; ++i) wv_[i] = __builtin_nontemporal_load(&W[(size_t)(k0 + 2 * i + (lane >> 5)) * N + n0 + (lane & 31)]);
#pragma unroll
    for (int i = 0; i < 32; ++i) scr[(2 * i + (lane >> 5)) * 33 + (lane & 31)] = wv_[i];
    asm volatile("s_waitcnt lgkmcnt(0)" ::: "memory");
    const int c = lane & 7;
#pragma unroll
    for (int j = 0; j < 4; ++j) { const int n = (lane >> 3) + 8 * j; const LAS float* s = scr + (8 * c) * 33 + n;
        u32x4 o; o.x = pk2(s[0 * 33], s[1 * 33]); o.y = pk2(s[2 * 33], s[3 * 33]); o.z = pk2(s[4 * 33], s[5 * 33]); o.w = pk2(s[6 * 33], s[7 * 33]);
        *(u32x4*)(WT + (size_t)(n0 + n) * K + k0 + 8 * c) = o; }
    asm volatile("s_waitcnt lgkmcnt(0)" ::: "memory");
}
constexpr int I_IN = 16 * (NIN / 32), I_OUT = 16 * 32, I_1 = 16 * 128, I_2 = 64 * 32, I_L = I_IN + I_OUT + I_1 + I_2;
DI void p0_item(KAP a, int l, int r, LAS float* scr, int lane) {
    uchar* wt = a->ws + WS_WT + (size_t)l * WT_LAYER;
    if (r < I_IN) { p0_transpose_item(a->in[I_WIN] + (size_t)l * DM * NIN, DM, NIN, (bf16_t*)(wt + WT_IN), scr, r, lane); return; } r -= I_IN;
    if (r < I_OUT) { p0_transpose_item(a->in[I_WOUT] + (size_t)l * DM * DM, DM, DM, (bf16_t*)(wt + WT_OUT), scr, r, lane); return; } r -= I_OUT;
    if (r < I_1) { p0_transpose_item(a->in[I_W1] + (size_t)l * DM * DFF, DM, DFF, (bf16_t*)(wt + WT_1), scr, r, lane); return; } r -= I_1;
    p0_transpose_item(a->in[I_W2] + (size_t)l * DFF * DM, DFF, DM, (bf16_t*)(wt + WT_2), scr, r, lane);
}
DI void p0_phase(KAP a, LAS uchar* lds, int wave, int lane, int G, bool do_mod) {
    LAS float* scr = (LAS float*)(lds + wave * 16384);
    const int gw = blockIdx.x * 8 + wave, NGW = G * 8;
    for (int it = gw; it < P0_ITEMS; it += NGW) p0_item(a, 0, it, scr, lane);
    float* mod = (float*)(a->ws + WS_MOD);
    for (int it = gw; it < (do_mod ? 2 * 96 * 8 : 0); it += NGW) {
        const int l = it / 768, r = it % 768, cgp = r >> 3, ks = r & 7;
#pragma unroll
        for (int rr = 0; rr < 3; ++rr) { const float* cv = rr == 0 ? a->in[I_CCTX] : a->in[I_C] + (rr - 1) * 1024;
            scr[rr * 128 + lane] = siluf_(cv[ks * 128 + lane]); scr[rr * 128 + 64 + lane] = siluf_(cv[ks * 128 + 64 + lane]); }
        asm volatile("s_waitcnt lgkmcnt(0)" ::: "memory");
        const float* w = a->in[I_WMOD] + ((size_t)l * 1024 + ks * 128) * 6144 + cgp * 64 + lane;
        float a0 = 0.f, a1 = 0.f, a2 = 0.f;
#pragma unroll 32
        for (int kk = 0; kk < 128; ++kk) { const float wv = __builtin_nontemporal_load(&w[(size_t)kk * 6144]); a0 += wv * scr[kk]; a1 += wv * scr[128 + kk]; a2 += wv * scr[256 + kk]; }
        if (ks == 0) { const float bv = a->in[I_BMOD][l * 6144 + cgp * 64 + lane]; a0 += bv; a1 += bv; a2 += bv; }
        float* mo = mod + (size_t)l * 3 * 6144 + cgp * 64 + lane;
        atomicAdd(mo, a0); atomicAdd(mo + 6144, a1); atomicAdd(mo + 2 * 6144, a2);
        asm volatile("s_waitcnt lgkmcnt(0)" ::: "memory");
    }
}

DI void shw_rows(KAP a, int l, int which, int wv, int nwv, int lane) {
    const int N = which ? DFF : NIN;
    const bf16_t* Wt = (const bf16_t*)(a->ws + WS_WT + (size_t)l * WT_LAYER + (which ? WT_1 : WT_IN));
    const float* modx = (const float*)(a->ws + WS_MOD) + (size_t)l * 3 * 6144 + (which ? 3 * 1024 : 0);
    float* so = (float*)(a->ws + WS_SHW) + (size_t)(l * 2 + which) * 3 * 4096;
    float sh[3][16];
#pragma unroll
    for (int r = 0; r < 3; ++r)
#pragma unroll
        for (int j = 0; j < 4; ++j) { const f32x4 v = *(const f32x4*)(modx + r * 6144 + 16 * lane + 4 * j); sh[r][4 * j] = v.x; sh[r][4 * j + 1] = v.y; sh[r][4 * j + 2] = v.z; sh[r][4 * j + 3] = v.w; }
    for (int n = wv; n < N; n += nwv) {
        float w[16]; unpack8(*(const u32x4*)(Wt + (size_t)n * DM + 16 * lane), w); unpack8(*(const u32x4*)(Wt + (size_t)n * DM + 16 * lane + 8), w + 8);
        float a0 = 0.f, a1 = 0.f, a2 = 0.f;
#pragma unroll
        for (int j = 0; j < 16; ++j) { a0 += w[j] * sh[0][j]; a1 += w[j] * sh[1][j]; a2 += w[j] * sh[2][j]; }
        a0 = wave_sum(a0); a1 = wave_sum(a1); a2 = wave_sum(a2);
        if (lane == 0) { so[n] = a0; so[4096 + n] = a1; so[2 * 4096 + n] = a2; }
    }
}
DI void norm_phase(KAP a, const float* srcP, const float* srcS, const float* nw, const float* modl, int sh_off, bf16_t* AH, float* rowss, int wave, int lane, int G) {
    const int gw = blockIdx.x * 8 + wave, NGW = G * 8;
    for (int m = gw; m < MT; m += NGW) {
        const float* xr = m < MP ? srcP + (size_t)m * DM : srcS + (size_t)(m - MP) * DM;
        const int rmod = m < MP ? 0 : 1 + ((m - MP) >> 11);
        const float* sc = modl + rmod * 6144 + sh_off + 1024;
        f32x4 v[4]; float ss = 0.f;
#pragma unroll
        for (int j = 0; j < 4; ++j) { v[j] = ((const f32x4*)xr)[lane + 64 * j]; ss += (v[j].x * v[j].x + v[j].y * v[j].y) + (v[j].z * v[j].z + v[j].w * v[j].w); }
        ss = wave_sum(ss);
        if (lane < 16) rowss[(size_t)m * 16 + lane] = lane == 0 ? ss : 0.f;
#pragma unroll
        for (int j = 0; j < 4; ++j) {
            const int col = 4 * (lane + 64 * j);
            const f32x4 g = *(const f32x4*)(nw + col), s1 = *(const f32x4*)(sc + col);
            const f32x4 hv = v[j] * g * (s1 + 1.f);
            u32x2 o; o.x = pk2(hv.x, hv.y); o.y = pk2(hv.z, hv.w);
            *(u32x2*)(AH + (size_t)m * DM + col) = o;
        }
    }
    shw_rows(a, 0, 0, gw, NGW, lane);
}

DI void prep_unit(KAP a, int l, int u, int tid, bool dummy_out) {
    const bf16_t* Yin = (const bf16_t*)(a->ws + WS_YIN);
    bf16_t* Yw = dummy_out ? (bf16_t*)(a->ws + WS_AMIX) : (bf16_t*)(a->ws + WS_YIN);
    const int ypitch = dummy_out ? 1024 : NIN;
    const int row0 = u * 64; const bool sample = row0 >= MP;
    const float* qkn = a->in[I_QKN] + l * 128;
#pragma unroll 8
    for (int i = 0; i < 16; ++i) {
        const int task = i * 512 + tid, sub = task & 7, grp = (task >> 3) & 15, tok = task >> 7;
        const int row = row0 + tok, isk = grp >> 3, g8 = grp & 7;
        const u32x4 w = *(const u32x4*)(Yin + (size_t)row * NIN + isk * 512 + g8 * 64 + sub * 8);
        float x[8]; unpack8(w, x);
        float ss = 0.f;
#pragma unroll
        for (int e = 0; e < 8; ++e) ss += x[e] * x[e];
        ss += __shfl_xor(ss, 1); ss += __shfl_xor(ss, 2); ss += __shfl_xor(ss, 4);
        const float rstd = rsqrtf(ss * (1.f / 64.f) + EPS);
        const f32x4 w0 = *(const f32x4*)(qkn + isk * 64 + sub * 8), w1 = *(const f32x4*)(qkn + isk * 64 + sub * 8 + 4);
        float y[8];
#pragma unroll
        for (int e = 0; e < 4; ++e) { y[e] = x[e] * rstd * w0[e]; y[4 + e] = x[4 + e] * rstd * w1[e]; }
        if (!sample) {
            if (isk && !dummy_out) { const int b = row >> 8, t = row & 255; float* o = a->out + O_CK + ((size_t)(b * 2 + l) * 256 + t) * 512 + g8 * 64 + sub * 8;
                __builtin_nontemporal_store((f32x4){y[0], y[1], y[2], y[3]}, (f32x4*)o); __builtin_nontemporal_store((f32x4){y[4], y[5], y[6], y[7]}, (f32x4*)(o + 4)); }
        } else {
            const int t = (row - MP) & 2047; const float pos = (float)((sub < 4) ? (t >> 6) : (t & 63));
#pragma unroll
            for (int e = 0; e < 8; ++e) {
                const float p = __shfl_xor(y[e], 2);
                const int f = 8 * (sub & 1) + e;
                const float inv = __builtin_amdgcn_exp2f(-(float)f * (13.287712379549449f / 16.f));
                const float ang = pos * inv; const float cs = __cosf(ang), sn = __sinf(ang);
                y[e] = ((sub & 2) == 0) ? (y[e] * cs - p * sn) : (p * sn + y[e] * cs);
            }
        }
        if (!isk) {
#pragma unroll
            for (int e = 0; e < 8; ++e) y[e] *= 0.125f * 1.4426950408889634f;
        }
        u32x4 o; o.x = pk2(y[0], y[1]); o.y = pk2(y[2], y[3]); o.z = pk2(y[4], y[5]); o.w = pk2(y[6], y[7]);
        *(u32x4*)(Yw + (size_t)row * ypitch + isk * 512 + g8 * 64 + sub * 8) = o;
    }
    if (!sample) {
#pragma unroll 8
        for (int i = 0; i < 8; ++i) {
            const int task = i * 512 + tid, c = task & 63, tok = task >> 6, row = row0 + tok, b = row >> 8, t = row & 255;
            const u32x4 w = *(const u32x4*)(Yin + (size_t)row * NIN + C_VA + c * 8);
            float x[8]; unpack8(w, x);
            float* o = a->out + O_CV + ((size_t)(b * 2 + l) * 256 + t) * 512 + c * 8;
            __builtin_nontemporal_store((f32x4){x[0], x[1], x[2], x[3]}, (f32x4*)o); __builtin_nontemporal_store((f32x4){x[4], x[5], x[6], x[7]}, (f32x4*)(o + 4));
        }
    }
}
DI void cachecvt_unit(KAP a, int l, int u, int tid) {
    bf16_t* Kc = (bf16_t*)(a->ws + WS_KC); bf16_t* Vc = (bf16_t*)(a->ws + WS_VC);
#pragma unroll 8
    for (int i = 0; i < 16; ++i) {
        const int task = i * 512 + tid, kv = task >> 12, rr = (task >> 6) & 63, c = task & 63;
        const int row = u * 64 + rr, b = row >> 8, t = row & 255;
        const float* src = a->in[kv ? I_CV : I_CK] + ((size_t)(b * 2 + l) * 256 + t) * 512 + c * 8;
        const f32x4 x0 = *(const f32x4*)src, x1 = *(const f32x4*)(src + 4);
        u32x4 o; o.x = pk2(x0.x, x0.y); o.y = pk2(x0.z, x0.w); o.z = pk2(x1.x, x1.y); o.w = pk2(x1.z, x1.w);
        *(u32x4*)((kv ? Vc : Kc) + (size_t)row * 512 + c * 8) = o;
    }
}
constexpr int XB_PITCH = 528;
template <int dir> DI void rgl_tile(int tb, int c, int hb, int ch, int r, int h, const bf16x8 (&wr_)[4], const bf16x8 (&wi_)[4], float b_r, float b_i, float logu,
                                     float& carry, float& pcar, const LAS uchar* XB, const LAS float* XF, bf16_t* HL, bf16_t* PC, size_t stmask) {
            f32x16 accR = {}, accI = {};
#pragma unroll
            for (int kk = 0; kk < 4; ++kk) {
                const bf16x8 af = *(const LAS bf16x8*)(XB + (32 * tb + r) * XB_PITCH + (64 * hb + 16 * kk + 8 * h) * 2);
                accR = MFMA32(af, wr_[kk], accR); accI = MFMA32(af, wi_[kk], accI);
            }
            float av[16], uv[16];
#pragma unroll
            for (int q = 0; q < 16; ++q) {
                const int tok = 32 * tb + crow(q, h);
                const float rg = sigmoidf_(accR[q] + b_r), ig = sigmoidf_(accI[q] + b_i);
                const float la = logu * rg; const float av_ = __expf(la);
                const float m2 = fmaxf(1.f - __expf(2.f * la), 0.f);
                av[q] = av_; uv[q] = __builtin_amdgcn_sqrtf(m2) * ig * XF[tok * 256 + ch];
            }
#pragma unroll
            for (int gi = 0; gi < 4; ++gi) {
                float hh = 0.f, p = 1.f;
#pragma unroll
                for (int kq = 0; kq < 4; ++kq) { const int q = 4 * gi + (dir ? 3 - kq : kq); hh = av[q] * hh + uv[q]; p = p * av[q]; uv[q] = hh; av[q] = p; }
            }
#pragma unroll
            for (int gq = 0; gq < 8; ++gq) {
                const int g = dir ? 7 - gq : gq; const int gi = g >> 1, owner = g & 1;
                const int qlast = 4 * gi + (dir ? 0 : 3);
                const float csel = (h == owner) ? carry : 0.f, psel = (h == owner) ? pcar : 1.f;
#pragma unroll
                for (int kq = 0; kq < 4; ++kq) { const int q = 4 * gi + kq; uv[q] = uv[q] + av[q] * csel; av[q] = av[q] * psel; }
                const float cn = (h == owner) ? uv[qlast] : carry, pn = (h == owner) ? av[qlast] : pcar;
                carry = __shfl(cn, r + 32 * owner); pcar = __shfl(pn, r + 32 * owner);
            }
#pragma unroll
            for (int q = 0; q < 16; ++q) {
                const size_t o = ((size_t)dir * MT + (size_t)c * 64 + 32 * tb + crow(q, h)) * 256 + ch;
                HL[o & stmask] = f2bf(uv[q]); PC[o & stmask] = f2bf(av[q]);
            }
        }
DI void rgl_local_unit(KAP a, int l, int c, LAS uchar* lds, int tid, bool fake_st = false) {
    const bf16_t* Yin = (const bf16_t*)(a->ws + WS_YIN);
    bf16_t* HL = (bf16_t*)(a->ws + WS_HL); bf16_t* PC = (bf16_t*)(a->ws + WS_PC);
    f32x2* SUM = (f32x2*)(a->ws + WS_SUM);
    const size_t stmask = fake_st ? (size_t)0x7fff : ~(size_t)0;
    const bool sample = c >= 128; const int L = sample ? 2048 : 256;
    const int cis = sample ? ((c - 128) & 31) : (c & 3);
    const int seqrow0 = c * 64 - cis * 64;
    LAS uchar* XB = lds; LAS float* XF = (LAS float*)(lds + 64 * XB_PITCH);
    const int lane = tid & 63, wave = tid >> 6, r = lane & 31, h = lane >> 5;
    const int dir = wave >> 2, hb = wave & 3;
    float wraw_r[2][32], wraw_i[2][32]; float b_r2[2], b_i2[2], lam2[2];
    {
        const float* rgw = a->in[I_RGW]; const float* rgb = a->in[I_RGB];
#pragma unroll
        for (int cb2 = 0; cb2 < 2; ++cb2) {
            const float* br = rgw + ((size_t)(((l * 2 + dir) * 2 + 0) * 4 + hb) * 64) * 64 + 32 * cb2 + r;
            const float* bi = rgw + ((size_t)(((l * 2 + dir) * 2 + 1) * 4 + hb) * 64) * 64 + 32 * cb2 + r;
#pragma unroll
            for (int kk = 0; kk < 4; ++kk)
#pragma unroll
                for (int j = 0; j < 8; ++j) { const int k = 16 * kk + 8 * h + j; wraw_r[cb2][8 * kk + j] = br[(size_t)k * 64]; wraw_i[cb2][8 * kk + j] = bi[(size_t)k * 64]; }
            const int ch = 64 * hb + 32 * cb2 + r;
            b_r2[cb2] = rgb[((l * 2 + dir) * 2 + 0) * 256 + ch]; b_i2[cb2] = rgb[((l * 2 + dir) * 2 + 1) * 256 + ch]; lam2[cb2] = a->in[I_RGL][(l * 2 + dir) * 256 + ch];
        }
    }
    {
        const int ch = tid & 255, half = tid >> 8;
        const float* cw = a->in[I_CW] + l * 1024; const float w0 = cw[ch], w1 = cw[256 + ch], w2 = cw[512 + ch], w3 = cw[768 + ch], cb = a->in[I_CB][l * 256 + ch];
        const int ts0 = cis * 64 + half * 32;
        const bf16_t* xp = Yin + (size_t)seqrow0 * NIN + C_XC + ch;
#define XLD(ts) (((ts) >= 0 && (ts) < L) ? bf2f(xp[(size_t)(ts) * NIN]) : 0.f)
        float xw[35];
#pragma unroll
        for (int tt = 0; tt < 35; ++tt) xw[tt] = XLD(ts0 + tt - 1);
#pragma unroll
        for (int tt = 0; tt < 32; ++tt) {
            const float v = cb + w0 * xw[tt] + w1 * xw[tt + 1] + w2 * xw[tt + 2] + w3 * xw[tt + 3];
            const int tok = half * 32 + tt;
            XF[tok * 256 + ch] = v; *(LAS unsigned short*)(XB + tok * XB_PITCH + ch * 2) = f2bf(v);
        }
#undef XLD
    }
    __syncthreads();
#pragma unroll
    for (int cb2 = 0; cb2 < 2; ++cb2) {
        const int ch = 64 * hb + 32 * cb2 + r;
        bf16x8 wr_[4], wi_[4];
#pragma unroll
        for (int kk = 0; kk < 4; ++kk) {
            u32x4 pr, pi;
#pragma unroll
            for (int j = 0; j < 4; ++j) { pr[j] = pk2(wraw_r[cb2][8 * kk + 2 * j], wraw_r[cb2][8 * kk + 2 * j + 1]); pi[j] = pk2(wraw_i[cb2][8 * kk + 2 * j], wraw_i[cb2][8 * kk + 2 * j + 1]); }
            wr_[kk] = __builtin_bit_cast(bf16x8, pr); wi_[kk] = __builtin_bit_cast(bf16x8, pi);
        }
        const float b_r = b_r2[cb2], b_i = b_i2[cb2];
        const float logu = -8.f * log1pf(__expf(-lam2[cb2]));
        float carry = 0.f, pcar = 1.f;
#pragma unroll 1
        for (int tbi = 0; tbi < 2; ++tbi) {
            const int tb = dir ? 1 - tbi : tbi;
            if (dir) rgl_tile<1>(tb, c, hb, ch, r, h, wr_, wi_, b_r, b_i, logu, carry, pcar, XB, XF, HL, PC, stmask);
            else rgl_tile<0>(tb, c, hb, ch, r, h, wr_, wi_, b_r, b_i, logu, carry, pcar, XB, XF, HL, PC, stmask);
        }
        if (h == 0) SUM[((size_t)dir * 192 + c) * 256 + ch] = (f32x2){pcar, carry};
    }
    __syncthreads();
}
DI void rgl_fixup_unit(KAP a, int l, int c, int tid) {
    const bf16_t* Yin = (const bf16_t*)(a->ws + WS_YIN);
    const bf16_t* HL = (const bf16_t*)(a->ws + WS_HL); const bf16_t* PC = (const bf16_t*)(a->ws + WS_PC);
    const f32x2* SUM = (const f32x2*)(a->ws + WS_SUM);
    bf16_t* Amix = (bf16_t*)(a->ws + WS_AMIX);
    const bool sample = c >= 128; const int nch = sample ? 32 : 4;
    const int cis = sample ? ((c - 128) & 31) : (c & 3), c0 = c - cis;
    const int b = sample ? ((c - 128) >> 5) : (c >> 2);
    const int ch = tid & 255, th = tid >> 8;
    float cf = sample ? a->in[I_SR][((b * 2 + l) * 2 + 0) * 256 + ch] : 0.f;
    for (int j0 = 0; j0 < cis; j0 += 8) {
        f32x2 s[8];
#pragma unroll
        for (int i = 0; i < 8; ++i) s[i] = (j0 + i < cis) ? SUM[((size_t)0 * 192 + c0 + j0 + i) * 256 + ch] : (f32x2){1.f, 0.f};
#pragma unroll
        for (int i = 0; i < 8; ++i) cf = s[i].x * cf + s[i].y;
    }
    float cbk = sample ? a->in[I_SR][((b * 2 + l) * 2 + 1) * 256 + ch] : 0.f;
    for (int j0 = nch - 1; j0 > cis; j0 -= 8) {
        f32x2 s[8];
#pragma unroll
        for (int i = 0; i < 8; ++i) s[i] = (j0 - i > cis) ? SUM[((size_t)1 * 192 + c0 + j0 - i) * 256 + ch] : (f32x2){1.f, 0.f};
#pragma unroll
        for (int i = 0; i < 8; ++i) cbk = s[i].x * cbk + s[i].y;
    }
    if (!sample && th == 0) {
        if (cis == nch - 1) { const f32x2 s = SUM[((size_t)0 * 192 + c) * 256 + ch]; a->out[O_SR + ((size_t)(b * 2 + l) * 2 + 0) * 256 + ch] = s.x * cf + s.y; }
        if (cis == 0) { const f32x2 s = SUM[((size_t)1 * 192 + c) * 256 + ch]; a->out[O_SR + ((size_t)(b * 2 + l) * 2 + 1) * 256 + ch] = s.x * cbk + s.y; }
    }
#pragma unroll 16
    for (int tt = 0; tt < 32; ++tt) {
        const size_t row = (size_t)c * 64 + th * 32 + tt;
        const float yf = bf2f(HL[row * 256 + ch]) + bf2f(PC[row * 256 + ch]) * cf;
        const float yr = bf2f(HL[((size_t)MT + row) * 256 + ch]) + bf2f(PC[((size_t)MT + row) * 256 + ch]) * cbk;
        const float g = bf2f(Yin[row * NIN + C_GC + ch]);
        Amix[row * DM + 768 + ch] = f2bf((yf + yr) * gelu_tanh(g));
    }
}


DI float hg_lbd(KAP a, int l, int dir, int col) {
    if (l == 0) return 0.f;
    const float h0 = a->in[I_HLB][(0 * 2 + dir) * 256 + col], h1 = a->in[I_HLB][(1 * 2 + dir) * 256 + col];
    return sigmoidf_(h1 - h0);
}
template <int dir> DI void hg_local_dir(KAP a, int l, int row0, int hd, int lane, LAS uchar* wl, const unsigned short (&fraw)[32], const float (&qs)[32]) {
    const bf16_t* Yin = (const bf16_t*)(a->ws + WS_YIN);
    bf16_t* HO = (bf16_t*)(a->ws + WS_HO); bf16_t* LL = (bf16_t*)(a->ws + WS_LL); float* DD = (float*)(a->ws + WS_DD);
    const int r = lane & 31, h = lane >> 5;
    LAS bf16_t* QP_ = (LAS bf16_t*)wl; LAS bf16_t* KP_ = (LAS bf16_t*)(wl + 4608); LAS uchar* KST = wl + 9216; const LAS uchar* VT = wl + 14336;
    const float lbd = hg_lbd(a, l, dir, hd * 64 + lane);
    float bb[32], kk[32];
#pragma unroll
    for (int t = 0; t < 32; ++t) { const float fp = bf2f(fraw[t]); const float f = lbd + (1.f - lbd) * sigmoidf_(fp); kk[t] = 1.f - f; bb[t] = __logf(f); }
    if (dir == 0) {
#pragma unroll
        for (int t = 1; t < 32; ++t) bb[t] += bb[t - 1];
    } else {
#pragma unroll
        for (int t = 30; t >= 0; --t) bb[t] += bb[t + 1];
    }
    const float ref = dir ? bb[16] : bb[15], blast = dir ? bb[0] : bb[31];
    const int id = ((row0 >> 5) * 4 + hd) * 2 + dir;
    DD[(size_t)id * 64 + lane] = __expf(blast);
    u32x4 kw[4];
#pragma unroll
    for (int t = 0; t < 32; t += 2) {
        const float q0 = qs[t], q1 = qs[t + 1];
        QP_[t * 72 + lane] = f2bf(q0 * __expf(bb[t] - ref)); QP_[(t + 1) * 72 + lane] = f2bf(q1 * __expf(bb[t + 1] - ref));
        KP_[t * 72 + lane] = f2bf(kk[t] * __expf(ref - bb[t])); KP_[(t + 1) * 72 + lane] = f2bf(kk[t + 1] * __expf(ref - bb[t + 1]));
        kw[t >> 3][(t >> 1) & 3] = pk2(kk[t] * __expf(blast - bb[t]), kk[t + 1] * __expf(blast - bb[t + 1]));
    }
#pragma unroll
    for (int i = 0; i < 4; ++i) *(LAS u32x4*)(KST + lane * 80 + 16 * i) = kw[i];
    asm volatile("s_waitcnt lgkmcnt(0)" ::: "memory");
    f32x16 X = {};
#pragma unroll
    for (int k4 = 0; k4 < 4; ++k4) {
        const bf16x8 kf = *(const LAS bf16x8*)(KP_ + r * 72 + 16 * k4 + 8 * h), qf = *(const LAS bf16x8*)(QP_ + r * 72 + 16 * k4 + 8 * h);
        X = MFMA32(kf, qf, X);
    }
#pragma unroll
    for (int q = 0; q < 16; ++q) { const int s = crow(q, h); const bool keep = dir ? (s >= r) : (s <= r); X[q] = keep ? X[q] : 0.f; }
    bf16x8 xs[2];
#pragma unroll
    for (int ks = 0; ks < 2; ++ks) { u32x4 pw; pw.x = pk2(X[8 * ks], X[8 * ks + 1]); pw.y = pk2(X[8 * ks + 2], X[8 * ks + 3]); pw.z = pk2(X[8 * ks + 4], X[8 * ks + 5]); pw.w = pk2(X[8 * ks + 6], X[8 * ks + 7]); xs[ks] = __builtin_bit_cast(bf16x8, pw); }
#pragma unroll
    for (int vb = 0; vb < 2; ++vb) {
        f32x16 Oi = {};
#pragma unroll
        for (int ks = 0; ks < 2; ++ks) {
            const LAS uchar* vp = VT + (32 * vb + r) * 80 + (16 * ks + 4 * h) * 2;
            const s16x4 lo = *(const LAS s16x4*)vp, hi = *(const LAS s16x4*)(vp + 16);
            const bf16x8 vf = __builtin_shufflevector(lo, hi, 0, 1, 2, 3, 4, 5, 6, 7);
            Oi = MFMA32(vf, xs[ks], Oi);
        }
        bf16_t* ho = HO + ((size_t)dir * MT + row0 + r) * 256 + hd * 64 + 32 * vb + 4 * h;
#pragma unroll
        for (int g4 = 0; g4 < 4; ++g4) { u32x2 o; o.x = pk2(Oi[4 * g4], Oi[4 * g4 + 1]); o.y = pk2(Oi[4 * g4 + 2], Oi[4 * g4 + 3]); *(u32x2*)(ho + 8 * g4) = o; }
    }
#pragma unroll
    for (int vb = 0; vb < 2; ++vb)
#pragma unroll
        for (int db = 0; db < 2; ++db) {
            f32x16 Lt = {};
#pragma unroll
            for (int ks = 0; ks < 2; ++ks) {
                const bf16x8 vf = *(const LAS bf16x8*)(VT + (32 * vb + r) * 80 + (16 * ks + 8 * h) * 2);
                const bf16x8 kf = *(const LAS bf16x8*)(KST + (32 * db + r) * 80 + (16 * ks + 8 * h) * 2);
                Lt = MFMA32(vf, kf, Lt);
            }
#pragma unroll
            for (int q = 0; q < 16; ++q) LL[(size_t)id * 4096 + (32 * vb + crow(q, h)) * 64 + 32 * db + r] = f2bf(Lt[q]);
        }
    asm volatile("s_waitcnt lgkmcnt(0)" ::: "memory");
}
DI void hgrn_local_unit(KAP a, int l, int u, LAS uchar* lds, int tid) {
    const bf16_t* Yin = (const bf16_t*)(a->ws + WS_YIN);
    const int lane = tid & 63, wave = tid >> 6, sc = wave >> 2, hd = wave & 3, row0 = u * 64 + sc * 32;
    LAS uchar* wl = lds + wave * 19456;
    const bf16_t* yc = Yin + (size_t)row0 * NIN + hd * 64 + lane;
    unsigned short vr[32], qr[32], f0[32], f1[32];
#pragma unroll
    for (int t = 0; t < 32; ++t) { vr[t] = yc[(size_t)t * NIN + C_IB]; qr[t] = yc[(size_t)t * NIN + C_QB]; f0[t] = yc[(size_t)t * NIN + C_FF]; f1[t] = yc[(size_t)t * NIN + C_FB]; }
    {
        u32x4 vw[4];
#pragma unroll
        for (int t = 0; t < 32; t += 2) vw[t >> 3][(t >> 1) & 3] = (unsigned)vr[t] | ((unsigned)vr[t + 1] << 16);
#pragma unroll
        for (int i = 0; i < 4; ++i) *(LAS u32x4*)(wl + 14336 + lane * 80 + 16 * i) = vw[i];
    }
    float qs[32];
#pragma unroll
    for (int t = 0; t < 32; ++t) qs[t] = siluf_(bf2f(qr[t]));
    hg_local_dir<0>(a, l, row0, hd, lane, wl, f0, qs);
    hg_local_dir<1>(a, l, row0, hd, lane, wl, f1, qs);
    __syncthreads();
}
DI void hgrn_chain_unit(KAP a, int l, bool sample, int b, int hd, int dir, int tid) {
    bf16_t* SIN = (bf16_t*)(a->ws + WS_SIN); const bf16_t* LL = (const bf16_t*)(a->ws + WS_LL); const float* DD = (const float*)(a->ws + WS_DD);
    const int v = tid >> 3, d0 = (tid & 7) * 8;
    const int nsub = sample ? 64 : 8, j0 = sample ? (MP + b * 2048) >> 5 : (b * 256) >> 5;
    float S[8];
#pragma unroll
    for (int e = 0; e < 8; ++e) S[e] = sample ? a->in[I_SH][((size_t)(((b * 2 + l) * 2 + dir) * 4 + hd) * 64 + d0 + e) * 64 + v] : 0.f;
    int id = ((dir ? j0 + nsub - 1 : j0) * 4 + hd) * 2 + dir; const int idstep = dir ? -8 : 8;
    u32x4 lw[2]; f32x4 da[2], db[2];
#pragma unroll
    for (int i = 0; i < 2; ++i) { const int idi = id + i * idstep; lw[i] = *(const u32x4*)(LL + (size_t)idi * 4096 + v * 64 + d0); da[i] = *(const f32x4*)(DD + (size_t)idi * 64 + d0); db[i] = *(const f32x4*)(DD + (size_t)idi * 64 + d0 + 4); }
#pragma unroll 1
    for (int jj = 0; jj < nsub; jj += 2) {
        u32x4 lc[2]; f32x4 dca[2], dcb[2];
#pragma unroll
        for (int i = 0; i < 2; ++i) { lc[i] = lw[i]; dca[i] = da[i]; dcb[i] = db[i]; }
        if (jj + 2 < nsub) {
#pragma unroll
            for (int i = 0; i < 2; ++i) { const int idi = id + (2 + i) * idstep; lw[i] = *(const u32x4*)(LL + (size_t)idi * 4096 + v * 64 + d0); da[i] = *(const f32x4*)(DD + (size_t)idi * 64 + d0); db[i] = *(const f32x4*)(DD + (size_t)idi * 64 + d0 + 4); }
        }
#pragma unroll
        for (int i = 0; i < 2; ++i) {
            u32x4 o; o.x = pk2(S[0], S[1]); o.y = pk2(S[2], S[3]); o.z = pk2(S[4], S[5]); o.w = pk2(S[6], S[7]);
            *(u32x4*)(SIN + (size_t)(id + i * idstep) * 4096 + v * 64 + d0) = o;
            float lf[8]; unpack8(lc[i], lf);
#pragma unroll
            for (int e = 0; e < 4; ++e) { S[e] = dca[i][e] * S[e] + lf[e]; S[4 + e] = dcb[i][e] * S[4 + e] + lf[4 + e]; }
        }
        id += 2 * idstep;
    }
    if (!sample) {
#pragma unroll
        for (int e = 0; e < 8; ++e) a->out[O_SH + ((size_t)(((b * 2 + l) * 2 + dir) * 4 + hd) * 64 + d0 + e) * 64 + v] = S[e];
    }
}
template <int dir> DI void hg_inter_dir(KAP a, int l, int row0, int hd, int lane, LAS uchar* wl, f32x16 (&OT)[2], const unsigned short (&fraw)[32], const float (&qs)[32], const bf16x8 (&sfr)[2][4], const u32x2 (&hor)[2][4]) {
    const int r = lane & 31, h = lane >> 5;
    LAS bf16_t* QI = (LAS bf16_t*)wl;
    const float lbd = hg_lbd(a, l, dir, hd * 64 + lane);
    float bb[32];
#pragma unroll
    for (int t = 0; t < 32; ++t) { const float fp = bf2f(fraw[t]); bb[t] = __logf(lbd + (1.f - lbd) * sigmoidf_(fp)); }
    if (dir == 0) {
#pragma unroll
        for (int t = 1; t < 32; ++t) bb[t] += bb[t - 1];
    } else {
#pragma unroll
        for (int t = 30; t >= 0; --t) bb[t] += bb[t + 1];
    }
    asm volatile("s_waitcnt lgkmcnt(0)" ::: "memory");
#pragma unroll
    for (int t = 0; t < 32; ++t) QI[t * 72 + lane] = f2bf(qs[t] * __expf(bb[t]));
    asm volatile("s_waitcnt lgkmcnt(0)" ::: "memory");
#pragma unroll
    for (int vb = 0; vb < 2; ++vb) {
#pragma unroll
        for (int k4 = 0; k4 < 4; ++k4) {
            const bf16x8 qf = *(const LAS bf16x8*)(QI + r * 72 + 16 * k4 + 8 * h);
            OT[vb] = MFMA32(sfr[vb][k4], qf, OT[vb]);
        }
#pragma unroll
        for (int g4 = 0; g4 < 4; ++g4) { const u32x2 w = hor[vb][g4];
            OT[vb][4 * g4] += __uint_as_float(w.x << 16); OT[vb][4 * g4 + 1] += __uint_as_float(w.x & 0xffff0000u); OT[vb][4 * g4 + 2] += __uint_as_float(w.y << 16); OT[vb][4 * g4 + 3] += __uint_as_float(w.y & 0xffff0000u); }
    }
    asm volatile("s_waitcnt lgkmcnt(0)" ::: "memory");
}
DI void hgrn_inter_unit(KAP a, int l, int u, LAS uchar* lds, int tid) {
    const bf16_t* Yin = (const bf16_t*)(a->ws + WS_YIN); bf16_t* Amix = (bf16_t*)(a->ws + WS_AMIX);
    const int lane = tid & 63, wave = tid >> 6, sc = wave >> 2, hd = wave & 3, row0 = u * 64 + sc * 32, r = lane & 31, h = lane >> 5;
    LAS uchar* wl = lds + wave * 16384;
    f32x16 OT[2]; OT[0] = (f32x16){}; OT[1] = (f32x16){};
    {
        const bf16_t* HO = (const bf16_t*)(a->ws + WS_HO); const bf16_t* SIN = (const bf16_t*)(a->ws + WS_SIN);
        const bf16_t* yc = Yin + (size_t)row0 * NIN + hd * 64 + lane;
        unsigned short qr[32], f0[32], f1[32];
#pragma unroll
        for (int t = 0; t < 32; ++t) { qr[t] = yc[(size_t)t * NIN + C_QB]; f0[t] = yc[(size_t)t * NIN + C_FF]; f1[t] = yc[(size_t)t * NIN + C_FB]; }
        bf16x8 sf[2][2][4]; u32x2 ho[2][2][4];
#pragma unroll
        for (int d_ = 0; d_ < 2; ++d_) { const int id = ((row0 >> 5) * 4 + hd) * 2 + d_;
#pragma unroll
            for (int vb = 0; vb < 2; ++vb) {
#pragma unroll
                for (int k4 = 0; k4 < 4; ++k4) sf[d_][vb][k4] = *(const bf16x8*)(SIN + (size_t)id * 4096 + (32 * vb + r) * 64 + 16 * k4 + 8 * h);
#pragma unroll
                for (int g4 = 0; g4 < 4; ++g4) ho[d_][vb][g4] = *(const u32x2*)(HO + ((size_t)d_ * MT + row0 + r) * 256 + hd * 64 + 32 * vb + 4 * h + 8 * g4);
            } }
        float qs[32];
#pragma unroll
        for (int t = 0; t < 32; ++t) qs[t] = siluf_(bf2f(qr[t]));
        hg_inter_dir<0>(a, l, row0, hd, lane, wl, OT, f0, qs, sf[0], ho[0]);
        hg_inter_dir<1>(a, l, row0, hd, lane, wl, OT, f1, qs, sf[1], ho[1]);
    }
    float ss = 0.f;
#pragma unroll
    for (int vb = 0; vb < 2; ++vb)
#pragma unroll
        for (int q = 0; q < 16; ++q) ss += OT[vb][q] * OT[vb][q];
    ss += __shfl_xor(ss, 32);
    const float rstd = rsqrtf(ss * (1.f / 64.f) + EPS);
    const float* onw = a->in[I_HON] + l * 64;
    const size_t row = (size_t)row0 + r;
#pragma unroll
    for (int vb = 0; vb < 2; ++vb)
#pragma unroll
        for (int g4 = 0; g4 < 4; ++g4) {
            const int v0 = 32 * vb + 8 * g4 + 4 * h;
            const u32x2 gw = *(const u32x2*)(Yin + row * NIN + C_GB + hd * 64 + v0); const f32x4 w = *(const f32x4*)(onw + v0);
            const float g0 = __uint_as_float(gw.x << 16), g1 = __uint_as_float(gw.x & 0xffff0000u), g2 = __uint_as_float(gw.y << 16), g3 = __uint_as_float(gw.y & 0xffff0000u);
            u32x2 o; o.x = pk2(OT[vb][4 * g4] * rstd * w.x * siluf_(g0), OT[vb][4 * g4 + 1] * rstd * w.y * siluf_(g1));
            o.y = pk2(OT[vb][4 * g4 + 2] * rstd * w.z * siluf_(g2), OT[vb][4 * g4 + 3] * rstd * w.w * siluf_(g3));
            *(u32x2*)(Amix + row * DM + 512 + hd * 64 + v0) = o;
        }
}

constexpr int KL_PITCH = 144, KL_MAP = 64 * KL_PITCH, VL_PITCH = 272, VL_OFF = 2 * KL_MAP, KV_BUF = VL_OFF + 64 * VL_PITCH;
static_assert(2 * KV_BUF <= RING_BYTES && 4 * 64 * 64 * 4 <= 2 * KV_BUF, "attention LDS");
typedef short v4i16_t __attribute__((ext_vector_type(4)));
DI s16x4 vtr(const LAS uchar* p) { return __builtin_bit_cast(s16x4, __builtin_amdgcn_ds_read_tr16_b64_v4i16((LAS v4i16_t*)p)); }
DI void attn_unit(KAP a, int l, bool sample, int b, int hd, int qb, LAS uchar* lds, int tid) {
    const bf16_t* Yin = (const bf16_t*)(a->ws + WS_YIN);
    const bf16_t* Kc = (const bf16_t*)(a->ws + WS_KC); const bf16_t* Vc = (const bf16_t*)(a->ws + WS_VC);
    bf16_t* Amix = (bf16_t*)(a->ws + WS_AMIX);
    const int lane = tid & 63, wave = tid >> 6, r = lane & 31, h = lane >> 5, qg = wave >> 1, mp = wave & 1;
    const int seqrow0 = sample ? MP + b * 2048 : b * 256, Lself = sample ? 2048 : 256, NT = sample ? 36 : 4;
    const float lam_init = 0.8f - 0.6f * __expf(-0.3f * (float)l);
    float lam;
    { const float* dl = a->in[I_DLAM] + l * 256; const float s1 = wave_sum(dl[lane] * dl[64 + lane]), s2 = wave_sum(dl[128 + lane] * dl[192 + lane]); lam = __expf(s1) - __expf(s2) + lam_init; }
    const size_t qrow = (size_t)seqrow0 + qb * 128 + qg * 32 + r;
    bf16x8 qf[4];
#pragma unroll
    for (int kk = 0; kk < 4; ++kk) qf[kk] = *(const bf16x8*)(Yin + qrow * NIN + C_QA + hd * 128 + mp * 64 + 16 * kk + 8 * h);
    const int skey = tid >> 4, sc = tid & 15;
    u32x4 kA[2], vA[2], kB[2], vB[2];
#define ATT_LOAD(kt, KS, VS) do { const int key0 = (kt) * 64; const bool self = key0 < Lself; \
        _Pragma("unroll") for (int i = 0; i < 2; ++i) { const int key = skey + 32 * i; \
            const size_t rr = self ? (size_t)(seqrow0 + key0 + key) : (size_t)(b * 256 + key0 - Lself + key); \
            KS[i] = self ? *(const u32x4*)(Yin + rr * NIN + C_KA + hd * 128 + sc * 8) : *(const u32x4*)(Kc + rr * 512 + hd * 128 + sc * 8); \
            VS[i] = self ? *(const u32x4*)(Yin + rr * NIN + C_VA + hd * 128 + sc * 8) : *(const u32x4*)(Vc + rr * 512 + hd * 128 + sc * 8); } } while (0)
#define ATT_STORE(buf, KS, VS) do { LAS uchar* bb_ = lds + (buf) * KV_BUF; \
        _Pragma("unroll") for (int i = 0; i < 2; ++i) { const int key = skey + 32 * i; \
            *(LAS u32x4*)(bb_ + (sc >> 3) * KL_MAP + key * KL_PITCH + (sc & 7) * 16) = KS[i]; \
            *(LAS u32x4*)(bb_ + VL_OFF + key * VL_PITCH + sc * 16) = VS[i]; } } while (0)
    f32x16 O[4];
#pragma unroll
    for (int vb = 0; vb < 4; ++vb) O[vb] = (f32x16){};
    float mrun = -1e30f, lrun = 0.f;
    const int i16 = lane & 15, q_ = i16 >> 2, p_ = i16 & 3, blk = (lane >> 4) & 1;
    ATT_LOAD(0, kA, vA); ATT_STORE(0, kA, vA);
    __syncthreads();
    ATT_LOAD(1, kB, vB); if (NT > 2) ATT_LOAD(2, kA, vA);
#pragma unroll 1
    for (int kt2 = 0; kt2 < NT; kt2 += 2) {
#pragma unroll
    for (int hf = 0; hf < 2; ++hf) {
        const int kt = kt2 + hf;
        const LAS uchar* bb = lds + hf * KV_BUF;
        f32x16 S[2];
        {
            bf16x8 kf[2][4];
#pragma unroll
            for (int kb = 0; kb < 2; ++kb)
#pragma unroll
                for (int kk = 0; kk < 4; ++kk) kf[kb][kk] = *(const LAS bf16x8*)(bb + mp * KL_MAP + (32 * kb + r) * KL_PITCH + (16 * kk + 8 * h) * 2);
            S[0] = (f32x16){}; S[1] = (f32x16){};
            __builtin_amdgcn_s_setprio(1);
#pragma unroll
            for (int kk = 0; kk < 4; ++kk) { S[0] = MFMA32(kf[0][kk], qf[kk], S[0]); S[1] = MFMA32(kf[1][kk], qf[kk], S[1]); }
            __builtin_amdgcn_s_setprio(0);
        }
        float mx = S[0][0];
#pragma unroll
        for (int q = 0; q < 16; ++q) { mx = fmaxf(mx, S[0][q]); mx = fmaxf(mx, S[1][q]); }
        mx = fmaxf(mx, __shfl_xor(mx, 32));
        if (__any(mx > mrun + 8.f)) {
            const float mnew = fmaxf(mrun, mx); const float alpha = __builtin_amdgcn_exp2f(mrun - mnew); mrun = mnew;
            lrun *= alpha;
#pragma unroll
            for (int vb = 0; vb < 4; ++vb) O[vb] = O[vb] * alpha;
        }
        float ls = 0.f;
#pragma unroll
        for (int kb = 0; kb < 2; ++kb)
#pragma unroll
            for (int q = 0; q < 16; ++q) { const float p = __builtin_amdgcn_exp2f(S[kb][q] - mrun); S[kb][q] = p; ls += p; }
        lrun += ls;
#pragma unroll
        for (int kb = 0; kb < 2; ++kb)
#pragma unroll
            for (int s = 0; s < 2; ++s) {
                u32x4 pw; pw.x = pk2(S[kb][8 * s], S[kb][8 * s + 1]); pw.y = pk2(S[kb][8 * s + 2], S[kb][8 * s + 3]); pw.z = pk2(S[kb][8 * s + 4], S[kb][8 * s + 5]); pw.w = pk2(S[kb][8 * s + 6], S[kb][8 * s + 7]);
                const bf16x8 pf = __builtin_bit_cast(bf16x8, pw);
                const LAS uchar* vp = bb + VL_OFF + (32 * kb + 16 * s + 4 * h + q_) * VL_PITCH + (16 * blk) * 2 + 8 * p_;
                bf16x8 vf[4];
#pragma unroll
                for (int vb = 0; vb < 4; ++vb) { const s16x4 lo = vtr(vp + vb * 64), hi = vtr(vp + vb * 64 + 8 * VL_PITCH); vf[vb] = __builtin_shufflevector(lo, hi, 0, 1, 2, 3, 4, 5, 6, 7); }
                __builtin_amdgcn_s_setprio(1);
#pragma unroll
                for (int vb = 0; vb < 4; ++vb) O[vb] = MFMA32(vf[vb], pf, O[vb]);
                __builtin_amdgcn_s_setprio(0);
            }
        if (hf == 0) { if (kt + 1 < NT) ATT_STORE(1, kB, vB); if (kt + 3 < NT) ATT_LOAD(kt + 3, kB, vB); }
        else { if (kt + 1 < NT) ATT_STORE(0, kA, vA); if (kt + 3 < NT) ATT_LOAD(kt + 3, kA, vA); }
        __syncthreads();
    }
    }
#undef ATT_LOAD
#undef ATT_STORE
    lrun += __shfl_xor(lrun, 32);
    const float inv = 1.f / lrun;
    LAS float* X = (LAS float*)lds + qg * 4096;
    if (mp == 1) {
        const float sc1 = inv * lam;
#pragma unroll
        for (int vb = 0; vb < 4; ++vb)
#pragma unroll
            for (int q = 0; q < 16; ++q) X[(vb * 16 + q) * 64 + lane] = O[vb][q] * sc1;
    }
    __syncthreads();
    if (mp == 0) {
        float ss = 0.f;
#pragma unroll
        for (int vb = 0; vb < 4; ++vb)
#pragma unroll
            for (int q = 0; q < 16; ++q) { const float o = O[vb][q] * inv - X[(vb * 16 + q) * 64 + lane]; O[vb][q] = o; ss += o * o; }
        ss += __shfl_xor(ss, 32);
        const float rs = rsqrtf(ss * (1.f / 128.f) + EPS) * (1.f - lam_init);
        const float* sw = a->in[I_SUBLN] + l * 128;
        bf16_t* orow = Amix + qrow * DM + hd * 128;
#pragma unroll
        for (int vb = 0; vb < 4; ++vb)
#pragma unroll
            for (int g4 = 0; g4 < 4; ++g4) {
                const int v0 = 32 * vb + 8 * g4 + 4 * h; const f32x4 w = *(const f32x4*)(sw + v0);
                u32x2 o; o.x = pk2(O[vb][4 * g4] * rs * w.x, O[vb][4 * g4 + 1] * rs * w.y); o.y = pk2(O[vb][4 * g4 + 2] * rs * w.z, O[vb][4 * g4 + 3] * rs * w.w);
                *(u32x2*)(orow + v0) = o;
            }
    }
    __syncthreads();
}
#define XB_TMO      128
#define XB_XCNT(j)  (256  + 64 * (j))
#define XB_XSUB(j)  (1280 + 64 * (j))
#define XB_XGEN(j)  (2304 + 64 * (j))
#define XB_TOP      3328
#define XB_TOPGEN   3392
#define XCD_BAR_WORDS 3456
#define XB_SPIN_CAP (1u << 18)

__device__ __forceinline__ unsigned xb_ld(unsigned* p)              { return __hip_atomic_load(p, __ATOMIC_RELAXED, __HIP_MEMORY_SCOPE_AGENT); }
__device__ __forceinline__ unsigned xb_add(unsigned* p, unsigned v) { return __hip_atomic_fetch_add(p, v, __ATOMIC_RELAXED, __HIP_MEMORY_SCOPE_AGENT); }
__device__ __forceinline__ unsigned xb_xcc_id() { return (unsigned)__builtin_amdgcn_s_getreg((3 << 11) | 20) & 0xFu; }
#define XB_SPIN(cond, bar) do { unsigned _sp = 0; while (cond) { __builtin_amdgcn_s_sleep(1); \
    if ((++_sp & 255u) == 0u) { if (xb_ld(&(bar)[XB_TMO])) break; if (_sp > XB_SPIN_CAP) { atomicAdd(&(bar)[XB_TMO], 1u); break; } } } } while (0)

struct XcdBarrier {
    unsigned* bar; unsigned x;
    volatile LAS unsigned* st;
};

__device__ __forceinline__ XcdBarrier xcd_barrier_post(unsigned* bar, volatile LAS unsigned* st) {
    XcdBarrier b; b.bar = bar; b.x = xb_xcc_id(); b.st = st;
    if (threadIdx.x == 0) (void)xb_add(&bar[XB_XCNT(b.x)], 1u);
    return b;
}
__device__ __forceinline__ void xcd_barrier_complete(unsigned* bar, unsigned x, unsigned& nloc, unsigned& nx) {
    const unsigned G = gridDim.x * gridDim.y * gridDim.z;
    unsigned sum, cnt, mine, sp = 0u;
    for (;;) {
        sum = 0u; cnt = 0u; mine = 0u;
#pragma unroll
        for (unsigned j = 0; j < 16; ++j) { const unsigned c = xb_ld(&bar[XB_XCNT(j)]); sum += c; cnt += (c > 0u) ? 1u : 0u; mine = (j == x) ? c : mine; }
        if (sum == G) break;
        __builtin_amdgcn_s_sleep(1);
        if ((++sp & 255u) == 0u) { if (xb_ld(&bar[XB_TMO])) break; if (sp > XB_SPIN_CAP) { atomicAdd(&bar[XB_TMO], 1u); break; } }
    }
    nloc = mine > 0u ? mine : 1u; nx = cnt > 0u ? cnt : 1u;
}

__device__ __forceinline__ void xcd_barrier(const XcdBarrier& b) {
    asm volatile("s_waitcnt vmcnt(0)" ::: "memory");
    __syncthreads();
    if (threadIdx.x == 0) {
        unsigned* bar = b.bar;
        __builtin_amdgcn_s_waitcnt(0);
        unsigned nloc = b.st[0], nx = b.st[1];
        if (nloc == 0u) { xcd_barrier_complete(bar, b.x, nloc, nx); b.st[0] = nloc; b.st[1] = nx; }
        const unsigned old = xb_add(&bar[XB_XSUB(b.x)], 1u);
        const unsigned gen = old / nloc;
        if (old + 1u == (gen + 1u) * nloc) {
            __builtin_amdgcn_fence(__ATOMIC_RELEASE, "agent");
            asm volatile("s_waitcnt vmcnt(0)" ::: "memory");
            const unsigned og = xb_add(&bar[XB_TOP], 1u);
            const unsigned tg = og / nx;
            if (og + 1u == (tg + 1u) * nx) xb_add(&bar[XB_TOPGEN], 1u);
            else XB_SPIN(xb_ld(&bar[XB_TOPGEN]) == tg, bar);
            __builtin_amdgcn_fence(__ATOMIC_ACQUIRE, "agent");
            xb_add(&bar[XB_XGEN(b.x)], 1u);
            asm volatile("s_waitcnt vmcnt(0)" ::: "memory");
        } else {
            XB_SPIN(xb_ld(&bar[XB_XGEN(b.x)]) == gen, bar);
            __builtin_amdgcn_fence(__ATOMIC_ACQUIRE, "agent");
            asm volatile("s_waitcnt vmcnt(0)" ::: "memory");
        }
    }
    __syncthreads();
}

#define GSYNC(phv) do { if ((phv) == CG_SYNC_PHASE) grid.sync(); else { XcdBarrier xb_; xb_.bar = (unsigned*)(((KAP)__builtin_amdgcn_kernarg_segment_ptr())->ws + WS_CTL) + CW_BAR; xb_.x = xbar.x; xb_.st = (volatile LAS unsigned*)s_ctl; xcd_barrier(xb_); } } while (0)
__global__ void __launch_bounds__(512, 2) mega_fwd(KArgs a_) {
    extern __shared__ __attribute__((aligned(16))) unsigned char lds_raw[];
    __shared__ __attribute__((aligned(16))) unsigned s_ctl[4];
    LAS uchar* lds = (LAS uchar*)lds_raw;
    const int G = gridDim.x;
    cg::grid_group grid = cg::this_grid();
    if (threadIdx.x == 0) { s_ctl[0] = 0u; s_ctl[1] = 0u; }
    __syncthreads();
    XcdBarrier xbar = xcd_barrier_post((unsigned*)(a_.ws + WS_CTL) + CW_BAR, (volatile LAS unsigned*)s_ctl);
    const int ph_lo = a_.ph_lo, ph_hi = a_.ph_hi;
#if EXTRA_SYNCS
#pragma unroll 1
    for (int i = 0; i < EXTRA_SYNCS; ++i) GSYNC(1);
#endif
#pragma unroll 1
    for (int pass = 0; pass < (PRE_K > 0 ? 2 : NPASS); ++pass) {
    if (pass) GSYNC(1);
    const int ph_end = (PRE_K > 0 && pass == 0) ? PRE_K + 1 : ph_hi;
#pragma unroll 1
    for (int ph = (pass ? 1 : ph_lo); ph < ph_end; ++ph) {
        KAP a = (KAP)__builtin_amdgcn_kernarg_segment_ptr(); asm volatile("" : "+s"(a));
        unsigned* ctl = (unsigned*)(a->ws + WS_CTL);
        float* xs = a->out;
        bf16_t* AH = (bf16_t*)(a->ws + WS_AH); bf16_t* YIN = (bf16_t*)(a->ws + WS_YIN); bf16_t* AMIX = (bf16_t*)(a->ws + WS_AMIX); bf16_t* HFF = (bf16_t*)(a->ws + WS_HFF);
        if (ph > 0 && ((ph - 1) % 9 == 6 || ph == 10)) continue;
        int tid_ = threadIdx.x; asm volatile("" : "+v"(tid_));
        const int tid = tid_, lane = tid & 63, wave = __builtin_amdgcn_readfirstlane(tid >> 6);
        const int nrep = ((ph > 0 && (ph - 1) % 9 == REP_SP) || (ph == 0 && REP_SP == 100)) ? 2 : 1;
#pragma unroll 1
        for (int rep = 0; rep < nrep; ++rep) {
        if (rep) GSYNC(1);
        if (ph == 0) {
            p0_phase(a, lds, wave, lane, G, rep == 0);
        } else {
            const int l = (ph - 1) / 9, sp = (ph - 1) % 9;
            const float* modl = (const float*)(a->ws + WS_MOD) + (size_t)l * 3 * 6144;
            uchar* wt = a->ws + WS_WT + (size_t)l * WT_LAYER;
            float* rsb = (float*)(a->ws + WS_RS); const float* shwb = (const float*)(a->ws + WS_SHW);
            if (sp == 0) {
                norm_phase(a, a->in[I_XP], a->in[I_XS], a->in[I_N1], modl, 0, AH, rsb, wave, lane, G);
            } else if (sp == 1) {
                pg8::Gemm g{AH, (const bf16_t*)(wt + WT_IN), MT, NIN, DM}; pg8::StaticOrder S; S.init(MT, NIN, G, (int)blockIdx.x);
                pg8::EpiBf16<0> E{YIN, NIN, shwb + (size_t)(l * 2 + 0) * 3 * 4096, 0, 0, 1.f, rsb + (size_t)(l * 2 + 0) * MT * 16, 4096};
                pg8::gemm_phase<pg8::EpiBf16<0>, pg8::StaticOrder, true, true>(lds, g, S, E);
            } else if (sp >= 2 && sp <= 4) {
                unsigned* ctr = ctl + CW_Q + 64 * (l * 3 + (sp - 2) + 8 * rep + 16 * pass);
                const int nunits = sp == 2 ? 584 : sp == 3 ? 656 + NFILL(l) : 384;
                for (int ustat = (int)blockIdx.x;; ustat += G) {
                    int u;
                    if (sp == 2 && STATIC_Q && BAL_PMA && G == 256) {
                        const int bx = (int)blockIdx.x, k_ = (ustat - bx) / G;
                        if (k_ >= 4) break;
                        if (bx < 192) u = k_ == 0 ? 392 + bx : k_ == 1 ? bx : -1;
                        else u = k_ < 3 ? 200 + (bx - 192) * 3 + k_ : (bx < 200 ? bx : -1);
                        if (u < 0) continue;
                    }
                    else if (sp != 3 && STATIC_Q) { u = ustat; }
                    else {
                        if (tid == 0) s_ctl[2] = atomicAdd(ctr, 1u);
                        __syncthreads();
                        u = (int)s_ctl[2];
                        __syncthreads();
                    }
                    if (u >= nunits) break;
                    int tq_ = tid; asm volatile("" : "+v"(tq_)); const int tidq = tq_;
                    if (sp == 2) {
                        if (u < 192) prep_unit(a, l, u, tidq, false);
                        else if (u < 200) cachecvt_unit(a, l, u - 192, tidq);
                        else if (u < 392) hgrn_local_unit(a, l, u - 200, lds, tidq);
                        else rgl_local_unit(a, l, u - 392, lds, tidq);
                    } else if (sp == 3) {
                        if (u < 16) { if (!DIS_HGRN) hgrn_chain_unit(a, l, true, u >> 3, (u >> 1) & 3, u & 1, tidq); }
                        else if (u < 144) { const int i = u - 16; if (!DIS_ATTN) attn_unit(a, l, true, i >> 6, (i >> 4) & 3, i & 15, lds, tidq); }
                        else if (u < 400) { const int i = u - 144; if (!DIS_HGRN) hgrn_chain_unit(a, l, false, i >> 3, (i >> 1) & 3, i & 1, tidq); }
                        else if (u < 656) { const int i = u - 400; if (!DIS_ATTN) attn_unit(a, l, false, i >> 3, (i >> 1) & 3, i & 1, lds, tidq); }
                        else { const int it = (u - 656) * 8 + (tidq >> 6) + FILL_FIRST(l); if (it < FILL_END(l)) p0_item(a, it / I_L, it % I_L, (LAS float*)(lds + (tidq >> 6) * 16384), tidq & 63); __syncthreads(); }
                    } else {
                        if (u < 192) { if (!DIS_FIX) rgl_fixup_unit(a, l, u, tidq); }
                        else { if (!DIS_HGRN) hgrn_inter_unit(a, l, u - 192, lds, tidq); }
                    }
                }
            } else if (sp == 5) {
                pg8::Gemm g{AMIX, (const bf16_t*)(wt + WT_OUT), MT, DM, DM}; pg8::StaticOrder S; S.init(MT, DM, G, (int)blockIdx.x);
                pg8::EpiResGate E{l == 0 ? a->in[I_XP] : xs, l == 0 ? a->in[I_XS] - (size_t)MP * DM : xs, rep ? (float*)(a->ws + WS_HFF) : xs, modl, 2 * 1024,
                                  a->in[I_N2] + l * DM, modl + 4 * 1024, AH, rsb + (size_t)(l * 2 + 1) * MT * 16, X1_BF16 ? (bf16_t*)(a->ws + WS_HL) : nullptr, nullptr};
                pg8::gemm_phase<pg8::EpiResGate, pg8::StaticOrder, true, true>(lds, g, S, E);
                {
                    const int nbusy = 192, bx = (int)blockIdx.x;
                    const bool spare = G > nbusy; const int wv = spare ? (bx - nbusy) * 8 + wave : bx * 8 + wave, nwv = spare ? (G - nbusy) * 8 : G * 8;
                    if (!spare || bx >= nbusy) shw_rows(a, l, 1, wv, nwv, lane);
                }
            } else if (sp == 7) {
                pg8::Gemm g{AH, (const bf16_t*)(wt + WT_1), MT, DFF, DM}; pg8::StaticOrder S; S.init(MT, DFF, G, (int)blockIdx.x);
                pg8::EpiBf16<2> E{HFF, DFF, shwb + (size_t)(l * 2 + 1) * 3 * 4096, 0, 0, 1.f, rsb + (size_t)(l * 2 + 1) * MT * 16, 4096};
                pg8::gemm_phase<pg8::EpiBf16<2>, pg8::StaticOrder, true, true>(lds, g, S, E);
            } else if (sp == 8) {
                pg8::Gemm g{HFF, (const bf16_t*)(wt + WT_2), MT, DM, DFF}; pg8::StaticOrder S; S.init(MT, DM, G, (int)blockIdx.x);
                const bool last = (l == 1);
                pg8::EpiResGate E{xs, xs, xs, modl, 5 * 1024,
                                  last ? nullptr : a->in[I_N1] + (l + 1) * DM, modl + 3 * 6144 + 1 * 1024, AH, rsb + (size_t)((l + 1) * 2 + 0) * MT * 16, nullptr, X1_BF16 ? (const bf16_t*)(a->ws + WS_HL) : nullptr};
                pg8::gemm_phase<pg8::EpiResGate, pg8::StaticOrder, true, true>(lds, g, S, E);
                if (!last) {
                    const int nbusy = 192, bx = (int)blockIdx.x;
                    const bool spare = G > nbusy; const int wv = spare ? (bx - nbusy) * 8 + wave : bx * 8 + wave, nwv = spare ? (G - nbusy) * 8 : G * 8;
                    if (!spare || bx >= nbusy) shw_rows(a, l + 1, 0, wv, nwv, lane);
                }
            }
        }
        }
        if (ph + 1 < ph_end) GSYNC(ph);
    }
    }
}

extern "C" void kernel_launch(void* const* d_in, const int* in_sizes, int n_in, void* d_out, int out_size, void* d_ws, size_t ws_size, hipStream_t stream) {
    static int grid = 0;
    if (grid == 0) {
        if (n_in != 26 || ws_size < WS_END) { fprintf(stderr, "kernel_launch: unexpected n_in %d / ws %zu\n", n_in, ws_size); grid = -1; return; }
        int dev = 0, cus = 0, per_cu = 0;
        hipGetDevice(&dev);
        hipDeviceGetAttribute(&cus, hipDeviceAttributeMultiprocessorCount, dev);
        if (hipFuncSetAttribute((const void*)mega_fwd, hipFuncAttributeMaxDynamicSharedMemorySize, LDS_BYTES) != hipSuccess) { fprintf(stderr, "kernel_launch: hipFuncSetAttribute failed\n"); grid = -1; return; }
        hipOccupancyMaxActiveBlocksPerMultiprocessor(&per_cu, (const void*)mega_fwd, 512, LDS_BYTES);
        if (per_cu < 1) { fprintf(stderr, "kernel_launch: occupancy query says %d blocks per CU\n", per_cu); per_cu = 1; }
        (void)hipGetLastError();
        grid = cus * per_cu;
        if (grid > 256) grid = 256;
    }
    if (grid < 0) return;
    hipMemsetAsync((char*)d_ws + WS_CTL, 0, CTL_BYTES, stream);
    KArgs a{};
    for (int i = 0; i < 26; ++i) a.in[i] = (const float*)d_in[i];
    a.out = (float*)d_out; a.ws = (uchar*)d_ws;
#if MK_COOP
    a.ph_lo = 0; a.ph_hi = NPHASE;
    void* args[] = {&a};
    hipError_t e = hipLaunchCooperativeKernel((const void*)mega_fwd, dim3(grid), dim3(512), args, LDS_BYTES, stream);
    if (e != hipSuccess) fprintf(stderr, "cooperative launch failed: %s (grid %d)\n", hipGetErrorString(e), grid);
#else
    for (int ph = 0; ph < NPHASE; ++ph) {
        a.ph_lo = ph; a.ph_hi = ph + 1;
        hipLaunchKernelGGL(mega_fwd, dim3(grid), dim3(512), LDS_BYTES, stream, a);
    }
#endif
}
```

```cpp
#include <hip/hip_runtime.h>
#include <hip/hip_cooperative_groups.h>
#include <cstdio>
#include <cstdint>
namespace cg = cooperative_groups;
#ifndef MK_COOP
#define MK_COOP 1
#endif
#ifndef DIS_PREP
#define DIS_PREP 0
#endif
#ifndef DIS_RGL
#define DIS_RGL 0
#endif
#ifndef DIS_HGRN
#define DIS_HGRN 0
#endif
#ifndef DIS_ATTN
#define DIS_ATTN 0
#endif
#ifndef DIS_FIX
#define DIS_FIX 0
#endif
#ifndef REP_SP
#define REP_SP (-1)
#endif
#ifndef EXTRA_SYNCS
#define EXTRA_SYNCS 0
#endif
#define P0_ITEMS (I_IN + I_OUT)
#define FILL_FIRST(l) ((l) == 0 ? P0_ITEMS : I_L + I_IN + I_OUT)
#define FILL_END(l) ((l) == 0 ? I_L + I_IN + I_OUT : 2 * I_L)
#define NFILL(l) ((FILL_END(l) - FILL_FIRST(l) + 7) / 8)
#ifndef NPASS
#define NPASS 1
#endif
#ifndef REP_ONLY
#define REP_ONLY 0
#endif
#ifndef STATIC_Q
#define STATIC_Q 0
#endif
#ifndef CG_SYNC_PHASE
#define CG_SYNC_PHASE 1000
#endif
#ifndef PRE_K
#define PRE_K 0
#endif
#ifndef BAL_PMA
#define BAL_PMA 0
#endif
#ifndef FAKE_ST
#define FAKE_ST 0
#endif
#ifndef SKIP_T
#define SKIP_T 0
#endif
#ifndef X1_BF16
#define X1_BF16 1
#endif
namespace pg8 {
#define PG8_LAS __attribute__((address_space(3)))
typedef unsigned short bf16_t;
typedef short bf16x8 __attribute__((ext_vector_type(8)));
typedef float f32x4 __attribute__((ext_vector_type(4)));
typedef unsigned u32x4 __attribute__((ext_vector_type(4)));
constexpr int BM = 256, BK = 64, HALF = 128, HTB = HALF * BK * 2  , STAGE_BYTES = 8 * HTB, NXCD = 8, WGM = 8;

__host__ __device__ __forceinline__ int lds_byte(int r, int c) { const int st = (r >> 4) * 2 + (c >> 5), rr = r & 15, cc = c & 31, ob = rr * 64 + cc * 2; return st * 1024 + (ob ^ (((ob >> 9) & 1) << 5)); }
__host__ __device__ __forceinline__ void stage_rc(int b, int& R, int& C) { const int st = b / 1024, sb = b % 1024, swz = sb ^ (((sb >> 9) & 1) << 5); R = (st >> 1) * 16 + swz / 64; C = (st & 1) * 32 + (swz % 64) / 2; }
__host__ __device__ __forceinline__ int perm32(int rho) { const int n = rho >> 4, i = rho & 15; return 8 * (i >> 2) + 4 * n + (i & 3); }

struct Unit { int pm, pn; };
struct Gemm { const bf16_t* A; const bf16_t* Bt; int M, N, K; };

struct StaticOrder {
    int nM, nN, nwg, G, c;
    __host__ __device__ void init(int M, int N, int G_, int c_) { nM = M / BM; nN = N / BM; nwg = nM * nN; G = G_; c = c_; }
    __host__ __device__ bool next(int i, Unit& u) const {
        const long L = (long)i * G + c; if (L >= nwg) return false;
        int wgid = (int)L; { const int q = nwg / NXCD, r = nwg % NXCD, xcd = wgid % NXCD, off = wgid / NXCD; wgid = (xcd < r ? xcd * (q + 1) : r * (q + 1) + (xcd - r) * q) + off; }
        const int nig = WGM * nN, gid = wgid / nig, fm = gid * WGM, gsz = (nM - fm) < WGM ? (nM - fm) : WGM;
        u.pm = fm + ((wgid % nig) % gsz); u.pn = (wgid % nig) / gsz; return true;
    }
    __device__ __forceinline__ void a_ready(const Unit&) const {}
    __device__ __forceinline__ void done(const Unit&) const {}
};

__device__ __forceinline__ unsigned cvt_pk_bf16(float lo, float hi) { unsigned r; asm volatile("v_cvt_pk_bf16_f32 %0, %1, %2" : "=v"(r) : "v"(lo), "v"(hi)); return r; }
typedef float f32x2 __attribute__((ext_vector_type(2)));
__device__ __forceinline__ f32x2 gelu_pk(f32x2 v) {
    const f32x2 av = __builtin_elementwise_abs(v), d = av * 0.2316418882f + 1.0f;
    f32x2 t; t.x = __builtin_amdgcn_rcpf(d.x); t.y = __builtin_amdgcn_rcpf(d.y);
    f32x2 q = t * 0.5307027145f + (-0.7265760135f); q = q * t + 0.7107068705f; q = q * t + (-0.142248368f); q = q * t + 0.127414796f; q = q * t;
    const f32x2 s = (v * v) * (-0.72134752044f);
    f32x2 e; e.x = __builtin_amdgcn_exp2f(s.x); e.y = __builtin_amdgcn_exp2f(s.y);
    const f32x2 m = v * (q * e), r = v - m;
    f32x2 o; o.x = v.x < 0.f ? m.x : r.x; o.y = v.y < 0.f ? m.y : r.y; return o;
}

template <int ACT  > struct EpiBf16 {
    static constexpr bool PERM = true, AFTER_DRAIN = false; static_assert(ACT >= 0 && ACT <= 2, "EpiBf16: ACT is 0 (none), 1 (gelu_pk) or 2 (relu squared)");
    bf16_t* O; int ldc; const float* bias; int split_cols; size_t split_stride; float scale0; const float* rowss; int bias_rstride;
    __device__ __forceinline__ void operator()(const f32x4 (&acc)[2][2][4][2], const Unit& u, int wr, int wc, int fr, int fq) const {
        const int row0 = u.pm * BM + wr * 64 + fr; int colt = u.pn * BM; bf16_t* base = O;
        float sc = 1.f; if (split_cols) { const int t = colt / split_cols; base += (size_t)t * split_stride; colt -= t * split_cols; if (t == 0) sc = scale0; }
        const int col0 = colt + wc * 32 + 8 * fq, bcol0 = u.pn * BM + wc * 32 + 8 * fq;
        f32x4 bv[2][2]; const float* biasr = bias ? bias + (size_t)(u.pm < 32 ? 0 : 1 + ((u.pm - 32) >> 3)) * bias_rstride : nullptr;
#pragma unroll
        for (int bj = 0; bj < 2; ++bj)
#pragma unroll
            for (int n = 0; n < 2; ++n) bv[bj][n] = biasr ? *(const f32x4*)(biasr + bcol0 + bj * HALF + 4 * n) : (f32x4){0.f, 0.f, 0.f, 0.f};
#pragma unroll
        for (int ai = 0; ai < 2; ++ai)
#pragma unroll
            for (int m = 0; m < 4; ++m) { bf16_t* rowp = base + (size_t)(row0 + ai * HALF + m * 16) * ldc + col0;
                float rs = 1.f; if (rowss) { const f32x4* rp = (const f32x4*)(rowss + (size_t)(row0 + ai * HALF + m * 16) * 16); const f32x4 s4 = (rp[0] + rp[1]) + (rp[2] + rp[3]); rs = __builtin_amdgcn_rsqf(((s4[0] + s4[1]) + (s4[2] + s4[3])) * (1.f / 1024.f) + 1e-6f); }
#pragma unroll
                for (int bj = 0; bj < 2; ++bj) { f32x4 v0 = acc[ai][bj][m][0] * rs + bv[bj][0], v1 = acc[ai][bj][m][1] * rs + bv[bj][1];
                    if (ACT == 1) { f32x2 a = gelu_pk((f32x2){v0[0], v0[1]}), b = gelu_pk((f32x2){v0[2], v0[3]}), c = gelu_pk((f32x2){v1[0], v1[1]}), d = gelu_pk((f32x2){v1[2], v1[3]});
                        v0 = (f32x4){a.x, a.y, b.x, b.y}; v1 = (f32x4){c.x, c.y, d.x, d.y}; }
                    if (ACT == 2) { v0 = __builtin_elementwise_max(v0, (f32x4){0.f, 0.f, 0.f, 0.f}); v1 = __builtin_elementwise_max(v1, (f32x4){0.f, 0.f, 0.f, 0.f}); v0 = v0 * v0; v1 = v1 * v1; }
                    v0 = v0 * sc; v1 = v1 * sc; u32x4 w; w.x = cvt_pk_bf16(v0[0], v0[1]); w.y = cvt_pk_bf16(v0[2], v0[3]); w.z = cvt_pk_bf16(v1[0], v1[1]); w.w = cvt_pk_bf16(v1[2], v1[3]);
                    *(u32x4*)(rowp + bj * HALF) = w; } }
    }
};

typedef unsigned u32x2v __attribute__((ext_vector_type(2)));

struct EpiResGate {
    static constexpr bool PERM = true, AFTER_DRAIN = false;
    const float* xinP; const float* xinS; float* xout; const float* modl; int gate_off;
    const float* nwn; const float* scn; bf16_t* An; float* rowss;
    bf16_t* xout16; const bf16_t* xin16;
    __device__ __forceinline__ void operator()(const f32x4 (&acc)[2][2][4][2], const Unit& u, int wr, int wc, int fr, int fq) const {
        const int rmod = u.pm < 32 ? 0 : 1 + ((u.pm - 32) >> 3);
        const float* g = modl + rmod * 6144 + gate_off; const float* xin = u.pm < 32 ? xinP : xinS;
        const int col0 = u.pn * BM + wc * 32 + 8 * fq;
        f32x4 gv[2][2], gs[2][2];
#pragma unroll
        for (int bj = 0; bj < 2; ++bj)
#pragma unroll
            for (int n = 0; n < 2; ++n) { gv[bj][n] = *(const f32x4*)(g + col0 + bj * HALF + n * 4);
                gs[bj][n] = nwn ? *(const f32x4*)(nwn + col0 + bj * HALF + n * 4) * (*(const f32x4*)(scn + rmod * 6144 + col0 + bj * HALF + n * 4) + 1.f) : (f32x4){0.f, 0.f, 0.f, 0.f}; }
#pragma unroll
        for (int ai = 0; ai < 2; ++ai)
#pragma unroll
            for (int m = 0; m < 4; ++m) { const int row = u.pm * BM + ai * HALF + wr * 64 + m * 16 + fr; const size_t off = (size_t)row * 1024 + col0;
                float ss = 0.f; u32x4 aw[2], xw[2];
#pragma unroll
                for (int bj = 0; bj < 2; ++bj)
#pragma unroll
                    for (int n = 0; n < 2; ++n) { f32x4 xv;
                        if (xin16) { const u32x2v w_ = *(const u32x2v*)(xin16 + off + bj * HALF + n * 4); xv = (f32x4){__uint_as_float(w_.x << 16), __uint_as_float(w_.x & 0xffff0000u), __uint_as_float(w_.y << 16), __uint_as_float(w_.y & 0xffff0000u)}; }
                        else xv = *(const f32x4*)(xin + off + bj * HALF + n * 4);
                        const f32x4 xo = xv + gv[bj][n] * acc[ai][bj][m][n];
                        if (xout16) { xw[bj][2 * n] = cvt_pk_bf16(xo[0], xo[1]); xw[bj][2 * n + 1] = cvt_pk_bf16(xo[2], xo[3]); }
                        else if (!nwn) __builtin_nontemporal_store(xo, (f32x4*)(xout + off + bj * HALF + n * 4));
                        else *(f32x4*)(xout + off + bj * HALF + n * 4) = xo;
                        if (nwn) { ss += (xo[0] * xo[0] + xo[1] * xo[1]) + (xo[2] * xo[2] + xo[3] * xo[3]); const f32x4 av = xo * gs[bj][n];
                            aw[bj][2 * n] = cvt_pk_bf16(av[0], av[1]); aw[bj][2 * n + 1] = cvt_pk_bf16(av[2], av[3]); } }
                if (nwn) {
#pragma unroll
                    for (int bj = 0; bj < 2; ++bj) *(u32x4*)(An + off + bj * HALF) = aw[bj]; }
                if (xout16) {
#pragma unroll
                    for (int bj = 0; bj < 2; ++bj) *(u32x4*)(xout16 + off + bj * HALF) = xw[bj]; }
                if (nwn) { ss += __shfl_xor(ss, 16); ss += __shfl_xor(ss, 32); if (fq == 0) rowss[(size_t)row * 16 + u.pn * 4 + wc] = ss; } }
    }
};
template <class Epi, class Sched, bool ALIGN_EPI = false, bool SP2 = false>
__device__ __forceinline__ void gemm_phase(PG8_LAS unsigned char* lds, const Gemm g, const Sched& S, const Epi& E) {
    int tid_ = threadIdx.x; asm volatile("" : "+v"(tid_)); const int tid = tid_, wid = __builtin_amdgcn_readfirstlane(tid >> 6), lane = tid & 63, wr = wid >> 2, wc = wid & 3, fr = lane & 15, fq = lane >> 4;
    const int K = g.K, nt = K / BK;
    unsigned voffA[2], voffB[2];
#pragma unroll
    for (int i = 0; i < 2; ++i) { int R, C; stage_rc(tid * 16 + i * 8192, R, C); const int Rb = Epi::PERM ? ((R & ~31) + perm32(R & 31)) : R;
        voffA[i] = (unsigned)(R * K + C) * 2u; voffB[i] = (unsigned)(Rb * K + C) * 2u; }
    const size_t kstep = (size_t)(BK * 2);
    const size_t hstep = (size_t)HALF * K * 2;
    const size_t tstep = 2 * hstep;
    const unsigned ldsw = (unsigned)wid * 1024u;
    const int aoff = lds_byte(wr * 64 + fr, fq * 8), boff = lds_byte(wc * 32 + fr, fq * 8);
#define PG8_SA(b, h) (((b) * 2 + (h)) * HTB)
#define PG8_SB(b, h) ((4 + (b) * 2 + (h)) * HTB)
#define PG8_STAGE(bufoff, gbase, voff) do { _Pragma("unroll") for (int _i = 0; _i < 2; ++_i) \
        __builtin_amdgcn_global_load_lds((const unsigned*)((const char*)(gbase) + (voff)[_i]), (PG8_LAS unsigned*)(lds + (bufoff) + ldsw + _i * 8192), 16, 0, 0); } while (0)
#define PG8_LDA(dst, b, h) do { _Pragma("unroll") for (int m = 0; m < 4; ++m) _Pragma("unroll") for (int k = 0; k < 2; ++k) dst[m][k] = *(const PG8_LAS bf16x8*)(lds + PG8_SA(b, h) + aoff + m * 2048 + k * 1024); } while (0)
#define PG8_LDB(dst, b, h) do { _Pragma("unroll") for (int n = 0; n < 2; ++n) _Pragma("unroll") for (int k = 0; k < 2; ++k) dst[n][k] = *(const PG8_LAS bf16x8*)(lds + PG8_SB(b, h) + boff + n * 2048 + k * 1024); } while (0)
#define PG8_MMA(ai, bj, At, Bt) do { __builtin_amdgcn_s_setprio(1); _Pragma("unroll") for (int m = 0; m < 4; ++m) _Pragma("unroll") for (int n = 0; n < 2; ++n) _Pragma("unroll") for (int k = 0; k < 2; ++k) \
        acc[ai][bj][m][n] = __builtin_amdgcn_mfma_f32_16x16x32_bf16(Bt[n][k], At[m][k], acc[ai][bj][m][n], 0, 0, 0); __builtin_amdgcn_s_setprio(0); } while (0)
#define PG8_WAIT_V(n) asm volatile("s_waitcnt vmcnt(" #n ")" ::: "memory")
#define PG8_WAIT_L(n) asm volatile("s_waitcnt lgkmcnt(" #n ")" ::: "memory")
#define PG8_BAR __builtin_amdgcn_s_barrier()
#define PG8_SCHED __builtin_amdgcn_sched_barrier(0)
    Unit cur, nxt; int ui = 0;
    if (!S.next(0, cur)) return;
    f32x4 acc[2][2][4][2];
#pragma unroll
    for (int a = 0; a < 2; ++a)
#pragma unroll
        for (int b = 0; b < 2; ++b)
#pragma unroll
            for (int m = 0; m < 4; ++m)
#pragma unroll
                for (int n = 0; n < 2; ++n) acc[a][b][m][n] = (f32x4){0.f, 0.f, 0.f, 0.f};
    bf16x8 At[4][2], B0[2][2], B1[2][2];
    const char* cA = (const char*)g.A + (size_t)cur.pm * tstep; const char* cB = (const char*)g.Bt + (size_t)cur.pn * tstep;
    S.a_ready(cur);
    if constexpr (SP2) {
        PG8_STAGE(PG8_SB(0, 0), cB, voffB); PG8_STAGE(PG8_SB(0, 1), cB + hstep, voffB); PG8_STAGE(PG8_SA(0, 0), cA, voffA); PG8_STAGE(PG8_SA(0, 1), cA + hstep, voffA);
        if (wr == 1) PG8_BAR;
        PG8_WAIT_V(2); PG8_BAR;
        PG8_STAGE(PG8_SB(1, 0), cB + kstep, voffB); PG8_STAGE(PG8_SA(1, 0), cA + kstep, voffA); PG8_STAGE(PG8_SB(1, 1), cB + hstep + kstep, voffB);
        PG8_WAIT_V(6); PG8_BAR;
    } else {
        PG8_STAGE(PG8_SB(0, 0), cB, voffB); PG8_STAGE(PG8_SA(0, 0), cA, voffA); PG8_STAGE(PG8_SB(0, 1), cB + hstep, voffB); PG8_STAGE(PG8_SA(0, 1), cA + hstep, voffA);
        if (wr == 1) PG8_BAR;
        PG8_WAIT_V(4); PG8_BAR;
        PG8_STAGE(PG8_SB(1, 0), cB + kstep, voffB); PG8_STAGE(PG8_SA(1, 0), cA + kstep, voffA); PG8_STAGE(PG8_SB(1, 1), cB + hstep + kstep, voffB);
        PG8_WAIT_V(6); PG8_BAR;
    }
    for (;;) {
        const bool has_next = S.next(ui + 1, nxt);
        const char* nA = has_next ? (const char*)g.A + (size_t)nxt.pm * tstep : cA; const char* nB = has_next ? (const char*)g.Bt + (size_t)nxt.pn * tstep : cB;
        for (int t = 0; t < nt; t += 2) {
            const bool last = (t == nt - 2);
            const char* a1 = cA + (size_t)(t + 1) * kstep;
            const char* a2 = last ? nA : cA + (size_t)(t + 2) * kstep; const char* b2 = last ? nB : cB + (size_t)(t + 2) * kstep;
            const char* a3 = a2 + kstep; const char* b3 = b2 + kstep;
            if (last && has_next) S.a_ready(nxt);
            if constexpr (SP2) {
            PG8_LDB(B0, 0, 0); PG8_LDB(B1, 0, 1); PG8_SCHED; PG8_LDA(At, 0, 0); PG8_STAGE(PG8_SA(1, 1), a1 + hstep, voffA);
            PG8_WAIT_V(8); PG8_WAIT_L(0); PG8_BAR; PG8_MMA(0, 0, At, B0); PG8_MMA(0, 1, At, B1); PG8_BAR; PG8_SCHED;
            PG8_LDA(At, 0, 1); PG8_STAGE(PG8_SB(0, 0), b2, voffB); PG8_STAGE(PG8_SB(0, 1), b2 + hstep, voffB); PG8_STAGE(PG8_SA(0, 0), a2, voffA);
            PG8_WAIT_V(8); PG8_WAIT_L(0); PG8_BAR; PG8_MMA(1, 0, At, B0); PG8_MMA(1, 1, At, B1); PG8_BAR; PG8_SCHED;
            PG8_LDB(B0, 1, 0); PG8_LDB(B1, 1, 1); PG8_SCHED; PG8_LDA(At, 1, 0); PG8_STAGE(PG8_SA(0, 1), a2 + hstep, voffA);
            PG8_WAIT_V(8); PG8_WAIT_L(0); PG8_BAR; PG8_MMA(0, 0, At, B0); PG8_MMA(0, 1, At, B1); PG8_BAR; PG8_SCHED;
            PG8_LDA(At, 1, 1); PG8_STAGE(PG8_SB(1, 0), b3, voffB); PG8_STAGE(PG8_SB(1, 1), b3 + hstep, voffB); PG8_STAGE(PG8_SA(1, 0), a3, voffA);
            PG8_WAIT_V(8); PG8_WAIT_L(0); PG8_BAR; PG8_MMA(1, 0, At, B0); PG8_MMA(1, 1, At, B1); PG8_BAR; PG8_SCHED;
            } else {
            PG8_LDB(B0, 0, 0); PG8_SCHED; PG8_LDA(At, 0, 0); PG8_STAGE(PG8_SA(1, 1), a1 + hstep, voffA);
            PG8_WAIT_L(8); PG8_BAR; PG8_WAIT_L(0); PG8_MMA(0, 0, At, B0); PG8_BAR; PG8_SCHED;
            PG8_LDB(B1, 0, 1); PG8_STAGE(PG8_SB(0, 0), b2, voffB);
            PG8_BAR; PG8_WAIT_L(0); PG8_MMA(0, 1, At, B1); PG8_BAR;
            PG8_LDA(At, 0, 1); PG8_STAGE(PG8_SA(0, 0), a2, voffA);
            PG8_BAR; PG8_WAIT_L(0); PG8_MMA(1, 0, At, B0); PG8_BAR; PG8_SCHED;
            PG8_STAGE(PG8_SB(0, 1), b2 + hstep, voffB);
            PG8_WAIT_V(6); PG8_BAR; PG8_MMA(1, 1, At, B1); PG8_BAR;
            PG8_LDB(B0, 1, 0); PG8_SCHED; PG8_LDA(At, 1, 0); PG8_STAGE(PG8_SA(0, 1), a2 + hstep, voffA);
            PG8_WAIT_L(8); PG8_BAR; PG8_WAIT_L(0); PG8_MMA(0, 0, At, B0); PG8_BAR; PG8_SCHED;
            PG8_LDB(B1, 1, 1); PG8_STAGE(PG8_SB(1, 0), b3, voffB);
            PG8_BAR; PG8_WAIT_L(0); PG8_MMA(0, 1, At, B1); PG8_BAR;
            PG8_LDA(At, 1, 1); PG8_STAGE(PG8_SA(1, 0), a3, voffA);
            PG8_BAR; PG8_WAIT_L(0); PG8_MMA(1, 0, At, B0); PG8_BAR; PG8_SCHED;
            PG8_STAGE(PG8_SB(1, 1), b3 + hstep, voffB);
            PG8_WAIT_V(6); PG8_BAR; PG8_MMA(1, 1, At, B1); PG8_BAR;
            }
        }
        if constexpr (ALIGN_EPI) { if (wr == 0) PG8_BAR; }
        if constexpr (!Epi::AFTER_DRAIN) { E(acc, cur, wr, wc, fr, fq); S.done(cur); }
        if (!has_next) break;
#pragma unroll
        for (int a = 0; a < 2; ++a)
#pragma unroll
            for (int b = 0; b < 2; ++b)
#pragma unroll
                for (int m = 0; m < 4; ++m)
#pragma unroll
                    for (int n = 0; n < 2; ++n) acc[a][b][m][n] = (f32x4){0.f, 0.f, 0.f, 0.f};
        cur = nxt; cA = nA; cB = nB; ++ui;
        if constexpr (ALIGN_EPI) { if (wr == 1) PG8_BAR; }
    }
    PG8_WAIT_V(0);
    if constexpr (!ALIGN_EPI) { if (wr == 0) PG8_BAR; }
    PG8_BAR;
    if constexpr (Epi::AFTER_DRAIN) { E.fused(acc, cur, wr, wc, fr, fq, lds, wid, lane); S.done(cur); }
#undef PG8_SA
#undef PG8_SB
#undef PG8_STAGE
#undef PG8_LDA
#undef PG8_LDB
#undef PG8_MMA
#undef PG8_WAIT_V
#undef PG8_WAIT_L
#undef PG8_BAR
#undef PG8_SCHED
}
}

#define LAS __attribute__((address_space(3)))
#define DI __device__ __forceinline__
typedef unsigned short bf16_t;
typedef unsigned char uchar;
typedef short bf16x8 __attribute__((ext_vector_type(8)));
typedef short s16x4 __attribute__((ext_vector_type(4)));
typedef float f32x4 __attribute__((ext_vector_type(4)));
typedef float f32x2 __attribute__((ext_vector_type(2)));
typedef float f32x16 __attribute__((ext_vector_type(16)));
typedef unsigned u32x4 __attribute__((ext_vector_type(4)));
typedef unsigned u32x2 __attribute__((ext_vector_type(2)));
typedef __bf16 bf16x2_t __attribute__((ext_vector_type(2)));

constexpr int DM = 1024, MP = 8192, MS = 4096, MT = 12288, NIN = 3328, DFF = 4096;
constexpr int C_QA = 0, C_KA = 512, C_VA = 1024, C_QB = 1536, C_FF = 1792, C_FB = 2048, C_IB = 2304, C_GB = 2560, C_XC = 2816, C_GC = 3072;
constexpr float EPS = 1e-6f;
constexpr size_t MiB = 1u << 20;
constexpr size_t WS_CTL = 0, CTL_BYTES = 1 * MiB, WS_MOD = 65536;
constexpr size_t WS_RS = 252 * MiB, WS_SHW = 704 * 1024;
constexpr size_t WS_SUM = 1 * MiB;
constexpr size_t WS_KC = 2 * MiB, WS_VC = 2 * MiB + 512 * 1024;
constexpr size_t WS_WT = 4 * MiB;
constexpr size_t WT_IN = 0, WT_OUT = (size_t)NIN * DM * 2, WT_1 = WT_OUT + (size_t)DM * DM * 2, WT_2 = WT_1 + (size_t)DFF * DM * 2, WT_LAYER = WT_2 + (size_t)DM * DFF * 2;
constexpr size_t WS_AH = 54 * MiB;
constexpr size_t WS_YIN = 78 * MiB;
constexpr size_t WS_SIN = 156 * MiB;
constexpr size_t WS_LL = 228 * MiB;
constexpr size_t WS_HO = 54 * MiB, WS_DD = 66 * MiB;
constexpr size_t WS_AMIX = 180 * MiB;
constexpr size_t WS_HL = 204 * MiB, WS_PC = 216 * MiB;
constexpr size_t WS_HFF = 78 * MiB;
constexpr size_t WS_END = 255 * MiB;
static_assert(WS_WT + 2 * WT_LAYER <= WS_AH && WS_HFF + (size_t)MT * DFF * 2 <= WS_AMIX, "ws map");
constexpr int RING_BYTES = 131072, LDS_BYTES = 147456;
constexpr int NPHASE = 19;
constexpr int CW_Q = 65536;
constexpr int CW_BAR = 4096;

struct KArgs {
    const float* in[26]; float* out; uchar* ws; int ph_lo, ph_hi;
};
typedef const __attribute__((address_space(4))) KArgs* KAP;
enum { I_XP = 0, I_XS, I_CK, I_CV, I_SH, I_SR, I_C, I_CCTX, I_WMOD, I_BMOD, I_N1, I_N2, I_WIN, I_WOUT, I_QKN, I_DLAM, I_SUBLN, I_HLB, I_HON, I_CW, I_CB, I_RGW, I_RGB, I_RGL, I_W1, I_W2 };
constexpr size_t O_YP = 0, O_YS = 8388608, O_CK = 12582912, O_CV = 20971520, O_SH = 29360128, O_SR = 31457280;

DI float bf2f(unsigned short b) { return __uint_as_float((unsigned)b << 16); }
DI unsigned pk2(float lo, float hi) { f32x2 v = {lo, hi}; bf16x2_t b = __builtin_convertvector(v, bf16x2_t); return __builtin_bit_cast(unsigned, b); }
DI unsigned short f2bf(float f) { return (unsigned short)(pk2(f, 0.f) & 0xffffu); }
DI void unpack8(const u32x4 w, float* x) {
#pragma unroll
    for (int i = 0; i < 4; ++i) { x[2 * i] = __uint_as_float(w[i] << 16); x[2 * i + 1] = __uint_as_float(w[i] & 0xffff0000u); }
}
DI float sigmoidf_(float x) { return __builtin_amdgcn_rcpf(1.f + __expf(-x)); }
DI float siluf_(float x) { return x * __builtin_amdgcn_rcpf(1.f + __expf(-x)); }
DI float gelu_tanh(float x) { const float y = 0.7978845608028654f * (x + 0.044715f * x * x * x); const float t = 1.f - 2.f * __builtin_amdgcn_rcpf(1.f + __expf(2.f * y)); return 0.5f * x * (1.f + t); }
DI float wave_sum(float v) {
#pragma unroll
    for (int o = 1; o < 64; o <<= 1) v += __shfl_xor(v, o);
    return v;
}
DI int crow(int reg, int h) { return (reg & 3) + 8 * (reg >> 2) + 4 * h; }
#define MFMA32(a, b, c) __builtin_amdgcn_mfma_f32_32x32x16_bf16((a), (b), (c), 0, 0, 0)

DI void p0_transpose_item(const float* W, int K, int N, bf16_t* WT, LAS float* scr, int item, int lane) {
    const int nblk = N / 32, kb = item / nblk, nb = item % nblk, k0 = 64 * kb, n0 = 32 * nb;
    float wv_[32];
#pragma unroll
    for (int i = 0; i < 32; ++i) wv_[i] = __builtin_nontemporal_load(&W[(size_t)(k0 + 2 * i + (lane >> 5)) * N + n0 + (lane & 31)]);
#pragma unroll
    for (int i = 0; i < 32; ++i) scr[(2 * i + (lane >> 5)) * 33 + (lane & 31)] = wv_[i];
    asm volatile("s_waitcnt lgkmcnt(0)" ::: "memory");
    const int c = lane & 7;
#pragma unroll
    for (int j = 0; j < 4; ++j) { const int n = (lane >> 3) + 8 * j; const LAS float* s = scr + (8 * c) * 33 + n;
        u32x4 o; o.x = pk2(s[0 * 33], s[1 * 33]); o.y = pk2(s[2 * 33], s[3 * 33]); o.z = pk2(s[4 * 33], s[5 * 33]); o.w = pk2(s[6 * 33], s[7 * 33]);
        *(u32x4*)(WT + (size_t)(n0 + n) * K + k0 + 8 * c) = o; }
    asm volatile("s_waitcnt lgkmcnt(0)" ::: "memory");
}
constexpr int I_IN = 16 * (NIN / 32), I_OUT = 16 * 32, I_1 = 16 * 128, I_2 = 64 * 32, I_L = I_IN + I_OUT + I_1 + I_2;
DI void p0_item(KAP a, int l, int r, LAS float* scr, int lane) {
    uchar* wt = a->ws + WS_WT + (size_t)l * WT_LAYER;
    if (r < I_IN) { p0_transpose_item(a->in[I_WIN] + (size_t)l * DM * NIN, DM, NIN, (bf16_t*)(wt + WT_IN), scr, r, lane); return; } r -= I_IN;
    if (r < I_OUT) { p0_transpose_item(a->in[I_WOUT] + (size_t)l * DM * DM, DM, DM, (bf16_t*)(wt + WT_OUT), scr, r, lane); return; } r -= I_OUT;
    if (r < I_1) { p0_transpose_item(a->in[I_W1] + (size_t)l * DM * DFF, DM, DFF, (bf16_t*)(wt + WT_1), scr, r, lane); return; } r -= I_1;
    p0_transpose_item(a->in[I_W2] + (size_t)l * DFF * DM, DFF, DM, (bf16_t*)(wt + WT_2), scr, r, lane);
}
DI void p0_phase(KAP a, LAS uchar* lds, int wave, int lane, int G, bool do_mod) {
    LAS float* scr = (LAS float*)(lds + wave * 16384);
    const int gw = blockIdx.x * 8 + wave, NGW = G * 8;
    for (int it = gw; it < P0_ITEMS; it += NGW) p0_item(a, 0, it, scr, lane);
    float* mod = (float*)(a->ws + WS_MOD);
    for (int it = gw; it < (do_mod ? 2 * 96 * 8 : 0); it += NGW) {
        const int l = it / 768, r = it % 768, cgp = r >> 3, ks = r & 7;
#pragma unroll
        for (int rr = 0; rr < 3; ++rr) { const float* cv = rr == 0 ? a->in[I_CCTX] : a->in[I_C] + (rr - 1) * 1024;
            scr[rr * 128 + lane] = siluf_(cv[ks * 128 + lane]); scr[rr * 128 + 64 + lane] = siluf_(cv[ks * 128 + 64 + lane]); }
        asm volatile("s_waitcnt lgkmcnt(0)" ::: "memory");
        const float* w = a->in[I_WMOD] + ((size_t)l * 1024 + ks * 128) * 6144 + cgp * 64 + lane;
        float a0 = 0.f, a1 = 0.f, a2 = 0.f;
#pragma unroll 32
        for (int kk = 0; kk < 128; ++kk) { const float wv = __builtin_nontemporal_load(&w[(size_t)kk * 6144]); a0 += wv * scr[kk]; a1 += wv * scr[128 + kk]; a2 += wv * scr[256 + kk]; }
        if (ks == 0) { const float bv = a->in[I_BMOD][l * 6144 + cgp * 64 + lane]; a0 += bv; a1 += bv; a2 += bv; }
        float* mo = mod + (size_t)l * 3 * 6144 + cgp * 64 + lane;
        atomicAdd(mo, a0); atomicAdd(mo + 6144, a1); atomicAdd(mo + 2 * 6144, a2);
        asm volatile("s_waitcnt lgkmcnt(0)" ::: "memory");
    }
}

DI void shw_rows(KAP a, int l, int which, int wv, int nwv, int lane) {
    const int N = which ? DFF : NIN;
    const bf16_t* Wt = (const bf16_t*)(a->ws + WS_WT + (size_t)l * WT_LAYER + (which ? WT_1 : WT_IN));
    const float* modx = (const float*)(a->ws + WS_MOD) + (size_t)l * 3 * 6144 + (which ? 3 * 1024 : 0);
    float* so = (float*)(a->ws + WS_SHW) + (size_t)(l * 2 + which) * 3 * 4096;
    float sh[3][16];
#pragma unroll
    for (int r = 0; r < 3; ++r)
#pragma unroll
        for (int j = 0; j < 4; ++j) { const f32x4 v = *(const f32x4*)(modx + r * 6144 + 16 * lane + 4 * j); sh[r][4 * j] = v.x; sh[r][4 * j + 1] = v.y; sh[r][4 * j + 2] = v.z; sh[r][4 * j + 3] = v.w; }
    for (int n = wv; n < N; n += nwv) {
        float w[16]; unpack8(*(const u32x4*)(Wt + (size_t)n * DM + 16 * lane), w); unpack8(*(const u32x4*)(Wt + (size_t)n * DM + 16 * lane + 8), w + 8);
        float a0 = 0.f, a1 = 0.f, a2 = 0.f;
#pragma unroll
        for (int j = 0; j < 16; ++j) { a0 += w[j] * sh[0][j]; a1 += w[j] * sh[1][j]; a2 += w[j] * sh[2][j]; }
        a0 = wave_sum(a0); a1 = wave_sum(a1); a2 = wave_sum(a2);
        if (lane == 0) { so[n] = a0; so[4096 + n] = a1; so[2 * 4096 + n] = a2; }
    }
}
DI void norm_phase(KAP a, const float* srcP, const float* srcS, const float* nw, const float* modl, int sh_off, bf16_t* AH, float* rowss, int wave, int lane, int G) {
    const int gw = blockIdx.x * 8 + wave, NGW = G * 8;
    for (int m = gw; m < MT; m += NGW) {
        const float* xr = m < MP ? srcP + (size_t)m * DM : srcS + (size_t)(m - MP) * DM;
        const int rmod = m < MP ? 0 : 1 + ((m - MP) >> 11);
        const float* sc = modl + rmod * 6144 + sh_off + 1024;
        f32x4 v[4]; float ss = 0.f;
#pragma unroll
        for (int j = 0; j < 4; ++j) { v[j] = ((const f32x4*)xr)[lane + 64 * j]; ss += (v[j].x * v[j].x + v[j].y * v[j].y) + (v[j].z * v[j].z + v[j].w * v[j].w); }
        ss = wave_sum(ss);
        if (lane < 16) rowss[(size_t)m * 16 + lane] = lane == 0 ? ss : 0.f;
#pragma unroll
        for (int j = 0; j < 4; ++j) {
            const int col = 4 * (lane + 64 * j);
            const f32x4 g = *(const f32x4*)(nw + col), s1 = *(const f32x4*)(sc + col);
            const f32x4 hv = v[j] * g * (s1 + 1.f);
            u32x2 o; o.x = pk2(hv.x, hv.y); o.y = pk2(hv.z, hv.w);
            *(u32x2*)(AH + (size_t)m * DM + col) = o;
        }
    }
    shw_rows(a, 0, 0, gw, NGW, lane);
}

DI void prep_unit(KAP a, int l, int u, int tid, bool dummy_out) {
    const bf16_t* Yin = (const bf16_t*)(a->ws + WS_YIN);
    bf16_t* Yw = dummy_out ? (bf16_t*)(a->ws + WS_AMIX) : (bf16_t*)(a->ws + WS_YIN);
    const int ypitch = dummy_out ? 1024 : NIN;
    const int row0 = u * 64; const bool sample = row0 >= MP;
    const float* qkn = a->in[I_QKN] + l * 128;
#pragma unroll 8
    for (int i = 0; i < 16; ++i) {
        const int task = i * 512 + tid, sub = task & 7, grp = (task >> 3) & 15, tok = task >> 7;
        const int row = row0 + tok, isk = grp >> 3, g8 = grp & 7;
        const u32x4 w = *(const u32x4*)(Yin + (size_t)row * NIN + isk * 512 + g8 * 64 + sub * 8);
        float x[8]; unpack8(w, x);
        float ss = 0.f;
#pragma unroll
        for (int e = 0; e < 8; ++e) ss += x[e] * x[e];
        ss += __shfl_xor(ss, 1); ss += __shfl_xor(ss, 2); ss += __shfl_xor(ss, 4);
        const float rstd = rsqrtf(ss * (1.f / 64.f) + EPS);
        const f32x4 w0 = *(const f32x4*)(qkn + isk * 64 + sub * 8), w1 = *(const f32x4*)(qkn + isk * 64 + sub * 8 + 4);
        float y[8];
#pragma unroll
        for (int e = 0; e < 4; ++e) { y[e] = x[e] * rstd * w0[e]; y[4 + e] = x[4 + e] * rstd * w1[e]; }
        if (!sample) {
            if (isk && !dummy_out) { const int b = row >> 8, t = row & 255; float* o = a->out + O_CK + ((size_t)(b * 2 + l) * 256 + t) * 512 + g8 * 64 + sub * 8;
                __builtin_nontemporal_store((f32x4){y[0], y[1], y[2], y[3]}, (f32x4*)o); __builtin_nontemporal_store((f32x4){y[4], y[5], y[6], y[7]}, (f32x4*)(o + 4)); }
        } else {
            const int t = (row - MP) & 2047; const float pos = (float)((sub < 4) ? (t >> 6) : (t & 63));
#pragma unroll
            for (int e = 0; e < 8; ++e) {
                const float p = __shfl_xor(y[e], 2);
                const int f = 8 * (sub & 1) + e;
                const float inv = __builtin_amdgcn_exp2f(-(float)f * (13.287712379549449f / 16.f));
                const float ang = pos * inv; const float cs = __cosf(ang), sn = __sinf(ang);
                y[e] = ((sub & 2) == 0) ? (y[e] * cs - p * sn) : (p * sn + y[e] * cs);
            }
        }
        if (!isk) {
#pragma unroll
            for (int e = 0; e < 8; ++e) y[e] *= 0.125f * 1.4426950408889634f;
        }
        u32x4 o; o.x = pk2(y[0], y[1]); o.y = pk2(y[2], y[3]); o.z = pk2(y[4], y[5]); o.w = pk2(y[6], y[7]);
        *(u32x4*)(Yw + (size_t)row * ypitch + isk * 512 + g8 * 64 + sub * 8) = o;
    }
    if (!sample) {
#pragma unroll 8
        for (int i = 0; i < 8; ++i) {
            const int task = i * 512 + tid, c = task & 63, tok = task >> 6, row = row0 + tok, b = row >> 8, t = row & 255;
            const u32x4 w = *(const u32x4*)(Yin + (size_t)row * NIN + C_VA + c * 8);
            float x[8]; unpack8(w, x);
            float* o = a->out + O_CV + ((size_t)(b * 2 + l) * 256 + t) * 512 + c * 8;
            __builtin_nontemporal_store((f32x4){x[0], x[1], x[2], x[3]}, (f32x4*)o); __builtin_nontemporal_store((f32x4){x[4], x[5], x[6], x[7]}, (f32x4*)(o + 4));
        }
    }
}
DI void cachecvt_unit(KAP a, int l, int u, int tid) {
    bf16_t* Kc = (bf16_t*)(a->ws + WS_KC); bf16_t* Vc = (bf16_t*)(a->ws + WS_VC);
#pragma unroll 8
    for (int i = 0; i < 16; ++i) {
        const int task = i * 512 + tid, kv = task >> 12, rr = (task >> 6) & 63, c = task & 63;
        const int row = u * 64 + rr, b = row >> 8, t = row & 255;
        const float* src = a->in[kv ? I_CV : I_CK] + ((size_t)(b * 2 + l) * 256 + t) * 512 + c * 8;
        const f32x4 x0 = *(const f32x4*)src, x1 = *(const f32x4*)(src + 4);
        u32x4 o; o.x = pk2(x0.x, x0.y); o.y = pk2(x0.z, x0.w); o.z = pk2(x1.x, x1.y); o.w = pk2(x1.z, x1.w);
        *(u32x4*)((kv ? Vc : Kc) + (size_t)row * 512 + c * 8) = o;
    }
}
constexpr int XB_PITCH = 528;
template <int dir> DI void rgl_tile(int tb, int c, int hb, int ch, int r, int h, const bf16x8 (&wr_)[4], const bf16x8 (&wi_)[4], float b_r, float b_i, float logu,
                                     float& carry, float& pcar, const LAS uchar* XB, const LAS float* XF, bf16_t* HL, bf16_t* PC, size_t stmask) {
            f32x16 accR = {}, accI = {};
#pragma unroll
            for (int kk = 0; kk < 4; ++kk) {
                const bf16x8 af = *(const LAS bf16x8*)(XB + (32 * tb + r) * XB_PITCH + (64 * hb + 16 * kk + 8 * h) * 2);
                accR = MFMA32(af, wr_[kk], accR); accI = MFMA32(af, wi_[kk], accI);
            }
            float av[16], uv[16];
#pragma unroll
            for (int q = 0; q < 16; ++q) {
                const int tok = 32 * tb + crow(q, h);
                const float rg = sigmoidf_(accR[q] + b_r), ig = sigmoidf_(accI[q] + b_i);
                const float la = logu * rg; const float av_ = __expf(la);
                const float m2 = fmaxf(1.f - __expf(2.f * la), 0.f);
                av[q] = av_; uv[q] = __builtin_amdgcn_sqrtf(m2) * ig * XF[tok * 256 + ch];
            }
#pragma unroll
            for (int gi = 0; gi < 4; ++gi) {
                float hh = 0.f, p = 1.f;
#pragma unroll
                for (int kq = 0; kq < 4; ++kq) { const int q = 4 * gi + (dir ? 3 - kq : kq); hh = av[q] * hh + uv[q]; p = p * av[q]; uv[q] = hh; av[q] = p; }
            }
#pragma unroll
            for (int gq = 0; gq < 8; ++gq) {
                const int g = dir ? 7 - gq : gq; const int gi = g >> 1, owner = g & 1;
                const int qlast = 4 * gi + (dir ? 0 : 3);
                const float csel = (h == owner) ? carry : 0.f, psel = (h == owner) ? pcar : 1.f;
#pragma unroll
                for (int kq = 0; kq < 4; ++kq) { const int q = 4 * gi + kq; uv[q] = uv[q] + av[q] * csel; av[q] = av[q] * psel; }
                const float cn = (h == owner) ? uv[qlast] : carry, pn = (h == owner) ? av[qlast] : pcar;
                carry = __shfl(cn, r + 32 * owner); pcar = __shfl(pn, r + 32 * owner);
            }
#pragma unroll
            for (int q = 0; q < 16; ++q) {
                const size_t o = ((size_t)dir * MT + (size_t)c * 64 + 32 * tb + crow(q, h)) * 256 + ch;
                HL[o & stmask] = f2bf(uv[q]); PC[o & stmask] = f2bf(av[q]);
            }
        }
DI void rgl_local_unit(KAP a, int l, int c, LAS uchar* lds, int tid, bool fake_st = false) {
    const bf16_t* Yin = (const bf16_t*)(a->ws + WS_YIN);
    bf16_t* HL = (bf16_t*)(a->ws + WS_HL); bf16_t* PC = (bf16_t*)(a->ws + WS_PC);
    f32x2* SUM = (f32x2*)(a->ws + WS_SUM);
    const size_t stmask = fake_st ? (size_t)0x7fff : ~(size_t)0;
    const bool sample = c >= 128; const int L = sample ? 2048 : 256;
    const int cis = sample ? ((c - 128) & 31) : (c & 3);
    const int seqrow0 = c * 64 - cis * 64;
    LAS uchar* XB = lds; LAS float* XF = (LAS float*)(lds + 64 * XB_PITCH);
    const int lane = tid & 63, wave = tid >> 6, r = lane & 31, h = lane >> 5;
    const int dir = wave >> 2, hb = wave & 3;
    float wraw_r[2][32], wraw_i[2][32]; float b_r2[2], b_i2[2], lam2[2];
    {
        const float* rgw = a->in[I_RGW]; const float* rgb = a->in[I_RGB];
#pragma unroll
        for (int cb2 = 0; cb2 < 2; ++cb2) {
            const float* br = rgw + ((size_t)(((l * 2 + dir) * 2 + 0) * 4 + hb) * 64) * 64 + 32 * cb2 + r;
            const float* bi = rgw + ((size_t)(((l * 2 + dir) * 2 + 1) * 4 + hb) * 64) * 64 + 32 * cb2 + r;
#pragma unroll
            for (int kk = 0; kk < 4; ++kk)
#pragma unroll
                for (int j = 0; j < 8; ++j) { const int k = 16 * kk + 8 * h + j; wraw_r[cb2][8 * kk + j] = br[(size_t)k * 64]; wraw_i[cb2][8 * kk + j] = bi[(size_t)k * 64]; }
            const int ch = 64 * hb + 32 * cb2 + r;
            b_r2[cb2] = rgb[((l * 2 + dir) * 2 + 0) * 256 + ch]; b_i2[cb2] = rgb[((l * 2 + dir) * 2 + 1) * 256 + ch]; lam2[cb2] = a->in[I_RGL][(l * 2 + dir) * 256 + ch];
        }
    }
    {
        const int ch = tid & 255, half = tid >> 8;
        const float* cw = a->in[I_CW] + l * 1024; const float w0 = cw[ch], w1 = cw[256 + ch], w2 = cw[512 + ch], w3 = cw[768 + ch], cb = a->in[I_CB][l * 256 + ch];
        const int ts0 = cis * 64 + half * 32;
        const bf16_t* xp = Yin + (size_t)seqrow0 * NIN + C_XC + ch;
#define XLD(ts) (((ts) >= 0 && (ts) < L) ? bf2f(xp[(size_t)(ts) * NIN]) : 0.f)
        float xw[35];
#pragma unroll
        for (int tt = 0; tt < 35; ++tt) xw[tt] = XLD(ts0 + tt - 1);
#pragma unroll
        for (int tt = 0; tt < 32; ++tt) {
            const float v = cb + w0 * xw[tt] + w1 * xw[tt + 1] + w2 * xw[tt + 2] + w3 * xw[tt + 3];
            const int tok = half * 32 + tt;
            XF[tok * 256 + ch] = v; *(LAS unsigned short*)(XB + tok * XB_PITCH + ch * 2) = f2bf(v);
        }
#undef XLD
    }
    __syncthreads();
#pragma unroll
    for (int cb2 = 0; cb2 < 2; ++cb2) {
        const int ch = 64 * hb + 32 * cb2 + r;
        bf16x8 wr_[4], wi_[4];
#pragma unroll
        for (int kk = 0; kk < 4; ++kk) {
            u32x4 pr, pi;
#pragma unroll
            for (int j = 0; j < 4; ++j) { pr[j] = pk2(wraw_r[cb2][8 * kk + 2 * j], wraw_r[cb2][8 * kk + 2 * j + 1]); pi[j] = pk2(wraw_i[cb2][8 * kk + 2 * j], wraw_i[cb2][8 * kk + 2 * j + 1]); }
            wr_[kk] = __builtin_bit_cast(bf16x8, pr); wi_[kk] = __builtin_bit_cast(bf16x8, pi);
        }
        const float b_r = b_r2[cb2], b_i = b_i2[cb2];
        const float logu = -8.f * log1pf(__expf(-lam2[cb2]));
        float carry = 0.f, pcar = 1.f;
#pragma unroll 1
        for (int tbi = 0; tbi < 2; ++tbi) {
            const int tb = dir ? 1 - tbi : tbi;
            if (dir) rgl_tile<1>(tb, c, hb, ch, r, h, wr_, wi_, b_r, b_i, logu, carry, pcar, XB, XF, HL, PC, stmask);
            else rgl_tile<0>(tb, c, hb, ch, r, h, wr_, wi_, b_r, b_i, logu, carry, pcar, XB, XF, HL, PC, stmask);
        }
        if (h == 0) SUM[((size_t)dir * 192 + c) * 256 + ch] = (f32x2){pcar, carry};
    }
    __syncthreads();
}
DI void rgl_fixup_unit(KAP a, int l, int c, int tid) {
    const bf16_t* Yin = (const bf16_t*)(a->ws + WS_YIN);
    const bf16_t* HL = (const bf16_t*)(a->ws + WS_HL); const bf16_t* PC = (const bf16_t*)(a->ws + WS_PC);
    const f32x2* SUM = (const f32x2*)(a->ws + WS_SUM);
    bf16_t* Amix = (bf16_t*)(a->ws + WS_AMIX);
    const bool sample = c >= 128; const int nch = sample ? 32 : 4;
    const int cis = sample ? ((c - 128) & 31) : (c & 3), c0 = c - cis;
    const int b = sample ? ((c - 128) >> 5) : (c >> 2);
    const int ch = tid & 255, th = tid >> 8;
    float cf = sample ? a->in[I_SR][((b * 2 + l) * 2 + 0) * 256 + ch] : 0.f;
    for (int j0 = 0; j0 < cis; j0 += 8) {
        f32x2 s[8];
#pragma unroll
        for (int i = 0; i < 8; ++i) s[i] = (j0 + i < cis) ? SUM[((size_t)0 * 192 + c0 + j0 + i) * 256 + ch] : (f32x2){1.f, 0.f};
#pragma unroll
        for (int i = 0; i < 8; ++i) cf = s[i].x * cf + s[i].y;
    }
    float cbk = sample ? a->in[I_SR][((b * 2 + l) * 2 + 1) * 256 + ch] : 0.f;
    for (int j0 = nch - 1; j0 > cis; j0 -= 8) {
        f32x2 s[8];
#pragma unroll
        for (int i = 0; i < 8; ++i) s[i] = (j0 - i > cis) ? SUM[((size_t)1 * 192 + c0 + j0 - i) * 256 + ch] : (f32x2){1.f, 0.f};
#pragma unroll
        for (int i = 0; i < 8; ++i) cbk = s[i].x * cbk + s[i].y;
    }
    if (!sample && th == 0) {
        if (cis == nch - 1) { const f32x2 s = SUM[((size_t)0 * 192 + c) * 256 + ch]; a->out[O_SR + ((size_t)(b * 2 + l) * 2 + 0) * 256 + ch] = s.x * cf + s.y; }
        if (cis == 0) { const f32x2 s = SUM[((size_t)1 * 192 + c) * 256 + ch]; a->out[O_SR + ((size_t)(b * 2 + l) * 2 + 1) * 256 + ch] = s.x * cbk + s.y; }
    }
#pragma unroll 16
    for (int tt = 0; tt < 32; ++tt) {
        const size_t row = (size_t)c * 64 + th * 32 + tt;
        const float yf = bf2f(HL[row * 256 + ch]) + bf2f(PC[row * 256 + ch]) * cf;
        const float yr = bf2f(HL[((size_t)MT + row) * 256 + ch]) + bf2f(PC[((size_t)MT + row) * 256 + ch]) * cbk;
        const float g = bf2f(Yin[row * NIN + C_GC + ch]);
        Amix[row * DM + 768 + ch] = f2bf((yf + yr) * gelu_tanh(g));
    }
}


DI float hg_lbd(KAP a, int l, int dir, int col) {
    if (l == 0) return 0.f;
    const float h0 = a->in[I_HLB][(0 * 2 + dir) * 256 + col], h1 = a->in[I_HLB][(1 * 2 + dir) * 256 + col];
    return sigmoidf_(h1 - h0);
}
template <int dir> DI void hg_local_dir(KAP a, int l, int row0, int hd, int lane, LAS uchar* wl, const unsigned short (&fraw)[32], const float (&qs)[32]) {
    const bf16_t* Yin = (const bf16_t*)(a->ws + WS_YIN);
    bf16_t* HO = (bf16_t*)(a->ws + WS_HO); bf16_t* LL = (bf16_t*)(a->ws + WS_LL); float* DD = (float*)(a->ws + WS_DD);
    const int r = lane & 31, h = lane >> 5;
    LAS bf16_t* QP_ = (LAS bf16_t*)wl; LAS bf16_t* KP_ = (LAS bf16_t*)(wl + 4608); LAS uchar* KST = wl + 9216; const LAS uchar* VT = wl + 14336;
    const float lbd = hg_lbd(a, l, dir, hd * 64 + lane);
    float bb[32], kk[32];
#pragma unroll
    for (int t = 0; t < 32; ++t) { const float fp = bf2f(fraw[t]); const float f = lbd + (1.f - lbd) * sigmoidf_(fp); kk[t] = 1.f - f; bb[t] = __logf(f); }
    if (dir == 0) {
#pragma unroll
        for (int t = 1; t < 32; ++t) bb[t] += bb[t - 1];
    } else {
#pragma unroll
        for (int t = 30; t >= 0; --t) bb[t] += bb[t + 1];
    }
    const float ref = dir ? bb[16] : bb[15], blast = dir ? bb[0] : bb[31];
    const int id = ((row0 >> 5) * 4 + hd) * 2 + dir;
    DD[(size_t)id * 64 + lane] = __expf(blast);
    u32x4 kw[4];
#pragma unroll
    for (int t = 0; t < 32; t += 2) {
        const float q0 = qs[t], q1 = qs[t + 1];
        QP_[t * 72 + lane] = f2bf(q0 * __expf(bb[t] - ref)); QP_[(t + 1) * 72 + lane] = f2bf(q1 * __expf(bb[t + 1] - ref));
        KP_[t * 72 + lane] = f2bf(kk[t] * __expf(ref - bb[t])); KP_[(t + 1) * 72 + lane] = f2bf(kk[t + 1] * __expf(ref - bb[t + 1]));
        kw[t >> 3][(t >> 1) & 3] = pk2(kk[t] * __expf(blast - bb[t]), kk[t + 1] * __expf(blast - bb[t + 1]));
    }
#pragma unroll
    for (int i = 0; i < 4; ++i) *(LAS u32x4*)(KST + lane * 80 + 16 * i) = kw[i];
    asm volatile("s_waitcnt lgkmcnt(0)" ::: "memory");
    f32x16 X = {};
#pragma unroll
    for (int k4 = 0; k4 < 4; ++k4) {
        const bf16x8 kf = *(const LAS bf16x8*)(KP_ + r * 72 + 16 * k4 + 8 * h), qf = *(const LAS bf16x8*)(QP_ + r * 72 + 16 * k4 + 8 * h);
        X = MFMA32(kf, qf, X);
    }
#pragma unroll
    for (int q = 0; q < 16; ++q) { const int s = crow(q, h); const bool keep = dir ? (s >= r) : (s <= r); X[q] = keep ? X[q] : 0.f; }
    bf16x8 xs[2];
#pragma unroll
    for (int ks = 0; ks < 2; ++ks) { u32x4 pw; pw.x = pk2(X[8 * ks], X[8 * ks + 1]); pw.y = pk2(X[8 * ks + 2], X[8 * ks + 3]); pw.z = pk2(X[8 * ks + 4], X[8 * ks + 5]); pw.w = pk2(X[8 * ks + 6], X[8 * ks + 7]); xs[ks] = __builtin_bit_cast(bf16x8, pw); }
#pragma unroll
    for (int vb = 0; vb < 2; ++vb) {
        f32x16 Oi = {};
#pragma unroll
        for (int ks = 0; ks < 2; ++ks) {
            const LAS uchar* vp = VT + (32 * vb + r) * 64 + (16 * ks + 4 * h) * 2;
            const s16x4 lo = *(const LAS s16x4*)vp, hi = *(const LAS s16x4*)(vp + 16);
            const bf16x8 vf = __builtin_shufflevector(lo, hi, 0, 1, 2, 3, 4, 5, 6, 7);
            Oi = MFMA32(vf, xs[ks], Oi);
        }
        bf16_t* ho = HO + ((size_t)dir * MT + row0 + r) * 256 + hd * 64 + 32 * vb + 4 * h;
#pragma unroll
        for (int g4 = 0; g4 < 4; ++g4) { u32x2 o; o.x = pk2(Oi[4 * g4], Oi[4 * g4 + 1]); o.y = pk2(Oi[4 * g4 + 2], Oi[4 * g4 + 3]); *(u32x2*)(ho + 8 * g4) = o; }
    }
#pragma unroll
    for (int vb = 0; vb < 2; ++vb)
#pragma unroll
        for (int db = 0; db < 2; ++db) {
            f32x16 Lt = {};
#pragma unroll
            for (int ks = 0; ks < 2; ++ks) {
                const bf16x8 vf = *(const LAS bf16x8*)(VT + (32 * vb + r) * 64 + (16 * ks + 8 * h) * 2);
                const bf16x8 kf = *(const LAS bf16x8*)(KST + (32 * db + r) * 80 + (16 * ks + 8 * h) * 2);
                Lt = MFMA32(vf, kf, Lt);
            }
#pragma unroll
            for (int q = 0; q < 16; ++q) LL[(size_t)id * 4096 + (32 * vb + crow(q, h)) * 64 + 32 * db + r] = f2bf(Lt[q]);
        }
    asm volatile("s_waitcnt lgkmcnt(0)" ::: "memory");
}
DI void hgrn_local_unit(KAP a, int l, int u, LAS uchar* lds, int tid) {
    const bf16_t* Yin = (const bf16_t*)(a->ws + WS_YIN);
    const int lane = tid & 63, wave = tid >> 6, sc = wave >> 2, hd = wave & 3, row0 = u * 64 + sc * 32;
    LAS uchar* wl = lds + wave * 18432;
    const bf16_t* yc = Yin + (size_t)row0 * NIN + hd * 64 + lane;
    unsigned short vr[32], qr[32], f0[32], f1[32];
#pragma unroll
    for (int t = 0; t < 32; ++t) { vr[t] = yc[(size_t)t * NIN + C_IB]; qr[t] = yc[(size_t)t * NIN + C_QB]; f0[t] = yc[(size_t)t * NIN + C_FF]; f1[t] = yc[(size_t)t * NIN + C_FB]; }
    {
        u32x4 vw[4];
#pragma unroll
        for (int t = 0; t < 32; t += 2) vw[t >> 3][(t >> 1) & 3] = (unsigned)vr[t] | ((unsigned)vr[t + 1] << 16);
#pragma unroll
        for (int i = 0; i < 4; ++i) *(LAS u32x4*)(wl + 14336 + lane * 64 + 16 * i) = vw[i];
    }
    float qs[32];
#pragma unroll
    for (int t = 0; t < 32; ++t) qs[t] = siluf_(bf2f(qr[t]));
    hg_local_dir<0>(a, l, row0, hd, lane, wl, f0, qs);
    hg_local_dir<1>(a, l, row0, hd, lane, wl, f1, qs);
    __syncthreads();
}
DI void hgrn_chain_unit(KAP a, int l, bool sample, int b, int hd, int dir, int tid) {
    bf16_t* SIN = (bf16_t*)(a->ws + WS_SIN); const bf16_t* LL = (const bf16_t*)(a->ws + WS_LL); const float* DD = (const float*)(a->ws + WS_DD);
    const int v = tid >> 3, d0 = (tid & 7) * 8;
    const int nsub = sample ? 64 : 8, j0 = sample ? (MP + b * 2048) >> 5 : (b * 256) >> 5;
    float S[8];
#pragma unroll
    for (int e = 0; e < 8; ++e) S[e] = sample ? a->in[I_SH][((size_t)(((b * 2 + l) * 2 + dir) * 4 + hd) * 64 + d0 + e) * 64 + v] : 0.f;
    int id = ((dir ? j0 + nsub - 1 : j0) * 4 + hd) * 2 + dir; const int idstep = dir ? -8 : 8;
    u32x4 lw[2]; f32x4 da[2], db[2];
#pragma unroll
    for (int i = 0; i < 2; ++i) { const int idi = id + i * idstep; lw[i] = *(const u32x4*)(LL + (size_t)idi * 4096 + v * 64 + d0); da[i] = *(const f32x4*)(DD + (size_t)idi * 64 + d0); db[i] = *(const f32x4*)(DD + (size_t)idi * 64 + d0 + 4); }
#pragma unroll 1
    for (int jj = 0; jj < nsub; jj += 2) {
        u32x4 lc[2]; f32x4 dca[2], dcb[2];
#pragma unroll
        for (int i = 0; i < 2; ++i) { lc[i] = lw[i]; dca[i] = da[i]; dcb[i] = db[i]; }
        if (jj + 2 < nsub) {
#pragma unroll
            for (int i = 0; i < 2; ++i) { const int idi = id + (2 + i) * idstep; lw[i] = *(const u32x4*)(LL + (size_t)idi * 4096 + v * 64 + d0); da[i] = *(const f32x4*)(DD + (size_t)idi * 64 + d0); db[i] = *(const f32x4*)(DD + (size_t)idi * 64 + d0 + 4); }
        }
#pragma unroll
        for (int i = 0; i < 2; ++i) {
            u32x4 o; o.x = pk2(S[0], S[1]); o.y = pk2(S[2], S[3]); o.z = pk2(S[4], S[5]); o.w = pk2(S[6], S[7]);
            *(u32x4*)(SIN + (size_t)(id + i * idstep) * 4096 + v * 64 + d0) = o;
            float lf[8]; unpack8(lc[i], lf);
#pragma unroll
            for (int e = 0; e < 4; ++e) { S[e] = dca[i][e] * S[e] + lf[e]; S[4 + e] = dcb[i][e] * S[4 + e] + lf[4 + e]; }
        }
        id += 2 * idstep;
    }
    if (!sample) {
#pragma unroll
        for (int e = 0; e < 8; ++e) a->out[O_SH + ((size_t)(((b * 2 + l) * 2 + dir) * 4 + hd) * 64 + d0 + e) * 64 + v] = S[e];
    }
}
template <int dir> DI void hg_inter_dir(KAP a, int l, int row0, int hd, int lane, LAS uchar* wl, f32x16 (&OT)[2], const unsigned short (&fraw)[32], const float (&qs)[32], const bf16x8 (&sfr)[2][4], const u32x2 (&hor)[2][4]) {
    const int r = lane & 31, h = lane >> 5;
    LAS bf16_t* QI = (LAS bf16_t*)wl;
    const float lbd = hg_lbd(a, l, dir, hd * 64 + lane);
    float bb[32];
#pragma unroll
    for (int t = 0; t < 32; ++t) { const float fp = bf2f(fraw[t]); bb[t] = __logf(lbd + (1.f - lbd) * sigmoidf_(fp)); }
    if (dir == 0) {
#pragma unroll
        for (int t = 1; t < 32; ++t) bb[t] += bb[t - 1];
    } else {
#pragma unroll
        for (int t = 30; t >= 0; --t) bb[t] += bb[t + 1];
    }
    asm volatile("s_waitcnt lgkmcnt(0)" ::: "memory");
#pragma unroll
    for (int t = 0; t < 32; ++t) QI[t * 72 + lane] = f2bf(qs[t] * __expf(bb[t]));
    asm volatile("s_waitcnt lgkmcnt(0)" ::: "memory");
#pragma unroll
    for (int vb = 0; vb < 2; ++vb) {
#pragma unroll
        for (int k4 = 0; k4 < 4; ++k4) {
            const bf16x8 qf = *(const LAS bf16x8*)(QI + r * 72 + 16 * k4 + 8 * h);
            OT[vb] = MFMA32(sfr[vb][k4], qf, OT[vb]);
        }
#pragma unroll
        for (int g4 = 0; g4 < 4; ++g4) { const u32x2 w = hor[vb][g4];
            OT[vb][4 * g4] += __uint_as_float(w.x << 16); OT[vb][4 * g4 + 1] += __uint_as_float(w.x & 0xffff0000u); OT[vb][4 * g4 + 2] += __uint_as_float(w.y << 16); OT[vb][4 * g4 + 3] += __uint_as_float(w.y & 0xffff0000u); }
    }
    asm volatile("s_waitcnt lgkmcnt(0)" ::: "memory");
}
DI void hgrn_inter_unit(KAP a, int l, int u, LAS uchar* lds, int tid) {
    const bf16_t* Yin = (const bf16_t*)(a->ws + WS_YIN); bf16_t* Amix = (bf16_t*)(a->ws + WS_AMIX);
    const int lane = tid & 63, wave = tid >> 6, sc = wave >> 2, hd = wave & 3, row0 = u * 64 + sc * 32, r = lane & 31, h = lane >> 5;
    LAS uchar* wl = lds + wave * 16384;
    f32x16 OT[2]; OT[0] = (f32x16){}; OT[1] = (f32x16){};
    {
        const bf16_t* HO = (const bf16_t*)(a->ws + WS_HO); const bf16_t* SIN = (const bf16_t*)(a->ws + WS_SIN);
        const bf16_t* yc = Yin + (size_t)row0 * NIN + hd * 64 + lane;
        unsigned short qr[32], f0[32], f1[32];
#pragma unroll
        for (int t = 0; t < 32; ++t) { qr[t] = yc[(size_t)t * NIN + C_QB]; f0[t] = yc[(size_t)t * NIN + C_FF]; f1[t] = yc[(size_t)t * NIN + C_FB]; }
        bf16x8 sf[2][2][4]; u32x2 ho[2][2][4];
#pragma unroll
        for (int d_ = 0; d_ < 2; ++d_) { const int id = ((row0 >> 5) * 4 + hd) * 2 + d_;
#pragma unroll
            for (int vb = 0; vb < 2; ++vb) {
#pragma unroll
                for (int k4 = 0; k4 < 4; ++k4) sf[d_][vb][k4] = *(const bf16x8*)(SIN + (size_t)id * 4096 + (32 * vb + r) * 64 + 16 * k4 + 8 * h);
#pragma unroll
                for (int g4 = 0; g4 < 4; ++g4) ho[d_][vb][g4] = *(const u32x2*)(HO + ((size_t)d_ * MT + row0 + r) * 256 + hd * 64 + 32 * vb + 4 * h + 8 * g4);
            } }
        float qs[32];
#pragma unroll
        for (int t = 0; t < 32; ++t) qs[t] = siluf_(bf2f(qr[t]));
        hg_inter_dir<0>(a, l, row0, hd, lane, wl, OT, f0, qs, sf[0], ho[0]);
        hg_inter_dir<1>(a, l, row0, hd, lane, wl, OT, f1, qs, sf[1], ho[1]);
    }
    float ss = 0.f;
#pragma unroll
    for (int vb = 0; vb < 2; ++vb)
#pragma unroll
        for (int q = 0; q < 16; ++q) ss += OT[vb][q] * OT[vb][q];
    ss += __shfl_xor(ss, 32);
    const float rstd = rsqrtf(ss * (1.f / 64.f) + EPS);
    const float* onw = a->in[I_HON] + l * 64;
    const size_t row = (size_t)row0 + r;
#pragma unroll
    for (int vb = 0; vb < 2; ++vb)
#pragma unroll
        for (int g4 = 0; g4 < 4; ++g4) {
            const int v0 = 32 * vb + 8 * g4 + 4 * h;
            const u32x2 gw = *(const u32x2*)(Yin + row * NIN + C_GB + hd * 64 + v0); const f32x4 w = *(const f32x4*)(onw + v0);
            const float g0 = __uint_as_float(gw.x << 16), g1 = __uint_as_float(gw.x & 0xffff0000u), g2 = __uint_as_float(gw.y << 16), g3 = __uint_as_float(gw.y & 0xffff0000u);
            u32x2 o; o.x = pk2(OT[vb][4 * g4] * rstd * w.x * siluf_(g0), OT[vb][4 * g4 + 1] * rstd * w.y * siluf_(g1));
            o.y = pk2(OT[vb][4 * g4 + 2] * rstd * w.z * siluf_(g2), OT[vb][4 * g4 + 3] * rstd * w.w * siluf_(g3));
            *(u32x2*)(Amix + row * DM + 512 + hd * 64 + v0) = o;
        }
}

constexpr int KL_PITCH = 144, KL_MAP = 64 * KL_PITCH, VL_PITCH = 288, VL_OFF = 2 * KL_MAP, KV_BUF = VL_OFF + 64 * VL_PITCH;
static_assert(2 * KV_BUF <= RING_BYTES && 4 * 64 * 64 * 4 <= 2 * KV_BUF, "attention LDS");
typedef short v4i16_t __attribute__((ext_vector_type(4)));
DI s16x4 vtr(const LAS uchar* p) { return __builtin_bit_cast(s16x4, __builtin_amdgcn_ds_read_tr16_b64_v4i16((LAS v4i16_t*)p)); }
DI void attn_unit(KAP a, int l, bool sample, int b, int hd, int qb, LAS uchar* lds, int tid) {
    const bf16_t* Yin = (const bf16_t*)(a->ws + WS_YIN);
    const bf16_t* Kc = (const bf16_t*)(a->ws + WS_KC); const bf16_t* Vc = (const bf16_t*)(a->ws + WS_VC);
    bf16_t* Amix = (bf16_t*)(a->ws + WS_AMIX);
    const int lane = tid & 63, wave = tid >> 6, r = lane & 31, h = lane >> 5, qg = wave >> 1, mp = wave & 1;
    const int seqrow0 = sample ? MP + b * 2048 : b * 256, Lself = sample ? 2048 : 256, NT = sample ? 36 : 4;
    const float lam_init = 0.8f - 0.6f * __expf(-0.3f * (float)l);
    float lam;
    { const float* dl = a->in[I_DLAM] + l * 256; const float s1 = wave_sum(dl[lane] * dl[64 + lane]), s2 = wave_sum(dl[128 + lane] * dl[192 + lane]); lam = __expf(s1) - __expf(s2) + lam_init; }
    const size_t qrow = (size_t)seqrow0 + qb * 128 + qg * 32 + r;
    bf16x8 qf[4];
#pragma unroll
    for (int kk = 0; kk < 4; ++kk) qf[kk] = *(const bf16x8*)(Yin + qrow * NIN + C_QA + hd * 128 + mp * 64 + 16 * kk + 8 * h);
    const int skey = tid >> 4, sc = tid & 15;
    u32x4 kA[2], vA[2], kB[2], vB[2];
#define ATT_LOAD(kt, KS, VS) do { const int key0 = (kt) * 64; const bool self = key0 < Lself; \
        _Pragma("unroll") for (int i = 0; i < 2; ++i) { const int key = skey + 32 * i; \
            const size_t rr = self ? (size_t)(seqrow0 + key0 + key) : (size_t)(b * 256 + key0 - Lself + key); \
            KS[i] = self ? *(const u32x4*)(Yin + rr * NIN + C_KA + hd * 128 + sc * 8) : *(const u32x4*)(Kc + rr * 512 + hd * 128 + sc * 8); \
            VS[i] = self ? *(const u32x4*)(Yin + rr * NIN + C_VA + hd * 128 + sc * 8) : *(const u32x4*)(Vc + rr * 512 + hd * 128 + sc * 8); } } while (0)
#define ATT_STORE(buf, KS, VS) do { LAS uchar* bb_ = lds + (buf) * KV_BUF; \
        _Pragma("unroll") for (int i = 0; i < 2; ++i) { const int key = skey + 32 * i; \
            *(LAS u32x4*)(bb_ + (sc >> 3) * KL_MAP + key * KL_PITCH + (sc & 7) * 16) = KS[i]; \
            *(LAS u32x4*)(bb_ + VL_OFF + key * VL_PITCH + sc * 16) = VS[i]; } } while (0)
    f32x16 O[4];
#pragma unroll
    for (int vb = 0; vb < 4; ++vb) O[vb] = (f32x16){};
    float mrun = -1e30f, lrun = 0.f;
    const int i16 = lane & 15, q_ = i16 >> 2, p_ = i16 & 3, blk = (lane >> 4) & 1;
    ATT_LOAD(0, kA, vA); ATT_STORE(0, kA, vA);
    __syncthreads();
    ATT_LOAD(1, kB, vB); if (NT > 2) ATT_LOAD(2, kA, vA);
#pragma unroll 1
    for (int kt2 = 0; kt2 < NT; kt2 += 2) {
#pragma unroll
    for (int hf = 0; hf < 2; ++hf) {
        const int kt = kt2 + hf;
        const LAS uchar* bb = lds + hf * KV_BUF;
        f32x16 S[2];
        {
            bf16x8 kf[2][4];
#pragma unroll
            for (int kb = 0; kb < 2; ++kb)
#pragma unroll
                for (int kk = 0; kk < 4; ++kk) kf[kb][kk] = *(const LAS bf16x8*)(bb + mp * KL_MAP + (32 * kb + r) * KL_PITCH + (16 * kk + 8 * h) * 2);
            S[0] = (f32x16){}; S[1] = (f32x16){};
            __builtin_amdgcn_s_setprio(1);
#pragma unroll
            for (int kk = 0; kk < 4; ++kk) { S[0] = MFMA32(kf[0][kk], qf[kk], S[0]); S[1] = MFMA32(kf[1][kk], qf[kk], S[1]); }
            __builtin_amdgcn_s_setprio(0);
        }
        float mx = S[0][0];
#pragma unroll
        for (int q = 0; q < 16; ++q) { mx = fmaxf(mx, S[0][q]); mx = fmaxf(mx, S[1][q]); }
        mx = fmaxf(mx, __shfl_xor(mx, 32));
        if (__any(mx > mrun + 8.f)) {
            const float mnew = fmaxf(mrun, mx); const float alpha = __builtin_amdgcn_exp2f(mrun - mnew); mrun = mnew;
            lrun *= alpha;
#pragma unroll
            for (int vb = 0; vb < 4; ++vb) O[vb] = O[vb] * alpha;
        }
        float ls = 0.f;
#pragma unroll
        for (int kb = 0; kb < 2; ++kb)
#pragma unroll
            for (int q = 0; q < 16; ++q) { const float p = __builtin_amdgcn_exp2f(S[kb][q] - mrun); S[kb][q] = p; ls += p; }
        lrun += ls;
#pragma unroll
        for (int kb = 0; kb < 2; ++kb)
#pragma unroll
            for (int s = 0; s < 2; ++s) {
                u32x4 pw; pw.x = pk2(S[kb][8 * s], S[kb][8 * s + 1]); pw.y = pk2(S[kb][8 * s + 2], S[kb][8 * s + 3]); pw.z = pk2(S[kb][8 * s + 4], S[kb][8 * s + 5]); pw.w = pk2(S[kb][8 * s + 6], S[kb][8 * s + 7]);
                const bf16x8 pf = __builtin_bit_cast(bf16x8, pw);
                const LAS uchar* vp = bb + VL_OFF + (32 * kb + 16 * s + 4 * h + q_) * VL_PITCH + (16 * blk) * 2 + 8 * p_;
                bf16x8 vf[4];
#pragma unroll
                for (int vb = 0; vb < 4; ++vb) { const s16x4 lo = vtr(vp + vb * 64), hi = vtr(vp + vb * 64 + 8 * VL_PITCH); vf[vb] = __builtin_shufflevector(lo, hi, 0, 1, 2, 3, 4, 5, 6, 7); }
                __builtin_amdgcn_s_setprio(1);
#pragma unroll
                for (int vb = 0; vb < 4; ++vb) O[vb] = MFMA32(vf[vb], pf, O[vb]);
                __builtin_amdgcn_s_setprio(0);
            }
        if (hf == 0) { if (kt + 1 < NT) ATT_STORE(1, kB, vB); if (kt + 3 < NT) ATT_LOAD(kt + 3, kB, vB); }
        else { if (kt + 1 < NT) ATT_STORE(0, kA, vA); if (kt + 3 < NT) ATT_LOAD(kt + 3, kA, vA); }
        __syncthreads();
    }
    }
#undef ATT_LOAD
#undef ATT_STORE
    lrun += __shfl_xor(lrun, 32);
    const float inv = 1.f / lrun;
    LAS float* X = (LAS float*)lds + qg * 4096;
    if (mp == 1) {
        const float sc1 = inv * lam;
#pragma unroll
        for (int vb = 0; vb < 4; ++vb)
#pragma unroll
            for (int q = 0; q < 16; ++q) X[(vb * 16 + q) * 64 + lane] = O[vb][q] * sc1;
    }
    __syncthreads();
    if (mp == 0) {
        float ss = 0.f;
#pragma unroll
        for (int vb = 0; vb < 4; ++vb)
#pragma unroll
            for (int q = 0; q < 16; ++q) { const float o = O[vb][q] * inv - X[(vb * 16 + q) * 64 + lane]; O[vb][q] = o; ss += o * o; }
        ss += __shfl_xor(ss, 32);
        const float rs = rsqrtf(ss * (1.f / 128.f) + EPS) * (1.f - lam_init);
        const float* sw = a->in[I_SUBLN] + l * 128;
        bf16_t* orow = Amix + qrow * DM + hd * 128;
#pragma unroll
        for (int vb = 0; vb < 4; ++vb)
#pragma unroll
            for (int g4 = 0; g4 < 4; ++g4) {
                const int v0 = 32 * vb + 8 * g4 + 4 * h; const f32x4 w = *(const f32x4*)(sw + v0);
                u32x2 o; o.x = pk2(O[vb][4 * g4] * rs * w.x, O[vb][4 * g4 + 1] * rs * w.y); o.y = pk2(O[vb][4 * g4 + 2] * rs * w.z, O[vb][4 * g4 + 3] * rs * w.w);
                *(u32x2*)(orow + v0) = o;
            }
    }
    __syncthreads();
}
#define XB_TMO      128
#define XB_XCNT(j)  (256  + 64 * (j))
#define XB_XSUB(j)  (1280 + 64 * (j))
#define XB_XGEN(j)  (2304 + 64 * (j))
#define XB_TOP      3328
#define XB_TOPGEN   3392
#define XCD_BAR_WORDS 3456
#define XB_SPIN_CAP (1u << 18)

__device__ __forceinline__ unsigned xb_ld(unsigned* p)              { return __hip_atomic_load(p, __ATOMIC_RELAXED, __HIP_MEMORY_SCOPE_AGENT); }
__device__ __forceinline__ unsigned xb_add(unsigned* p, unsigned v) { return __hip_atomic_fetch_add(p, v, __ATOMIC_RELAXED, __HIP_MEMORY_SCOPE_AGENT); }
__device__ __forceinline__ unsigned xb_xcc_id() { return (unsigned)__builtin_amdgcn_s_getreg((3 << 11) | 20) & 0xFu; }
#define XB_SPIN(cond, bar) do { unsigned _sp = 0; while (cond) { __builtin_amdgcn_s_sleep(1); \
    if ((++_sp & 255u) == 0u) { if (xb_ld(&(bar)[XB_TMO])) break; if (_sp > XB_SPIN_CAP) { atomicAdd(&(bar)[XB_TMO], 1u); break; } } } } while (0)

struct XcdBarrier {
    unsigned* bar; unsigned x;
    volatile LAS unsigned* st;
};

__device__ __forceinline__ XcdBarrier xcd_barrier_post(unsigned* bar, volatile LAS unsigned* st) {
    XcdBarrier b; b.bar = bar; b.x = xb_xcc_id(); b.st = st;
    if (threadIdx.x == 0) (void)xb_add(&bar[XB_XCNT(b.x)], 1u);
    return b;
}
__device__ __forceinline__ void xcd_barrier_complete(unsigned* bar, unsigned x, unsigned& nloc, unsigned& nx) {
    const unsigned G = gridDim.x * gridDim.y * gridDim.z;
    unsigned sum, cnt, mine, sp = 0u;
    for (;;) {
        sum = 0u; cnt = 0u; mine = 0u;
#pragma unroll
        for (unsigned j = 0; j < 16; ++j) { const unsigned c = xb_ld(&bar[XB_XCNT(j)]); sum += c; cnt += (c > 0u) ? 1u : 0u; mine = (j == x) ? c : mine; }
        if (sum == G) break;
        __builtin_amdgcn_s_sleep(1);
        if ((++sp & 255u) == 0u) { if (xb_ld(&bar[XB_TMO])) break; if (sp > XB_SPIN_CAP) { atomicAdd(&bar[XB_TMO], 1u); break; } }
    }
    nloc = mine > 0u ? mine : 1u; nx = cnt > 0u ? cnt : 1u;
}

__device__ __forceinline__ void xcd_barrier(const XcdBarrier& b) {
    asm volatile("s_waitcnt vmcnt(0)" ::: "memory");
    __syncthreads();
    if (threadIdx.x == 0) {
        unsigned* bar = b.bar;
        __builtin_amdgcn_s_waitcnt(0);
        unsigned nloc = b.st[0], nx = b.st[1];
        if (nloc == 0u) { xcd_barrier_complete(bar, b.x, nloc, nx); b.st[0] = nloc; b.st[1] = nx; }
        const unsigned old = xb_add(&bar[XB_XSUB(b.x)], 1u);
        const unsigned gen = old / nloc;
        if (old + 1u == (gen + 1u) * nloc) {
            __builtin_amdgcn_fence(__ATOMIC_RELEASE, "agent");
            asm volatile("s_waitcnt vmcnt(0)" ::: "memory");
            const unsigned og = xb_add(&bar[XB_TOP], 1u);
            const unsigned tg = og / nx;
            if (og + 1u == (tg + 1u) * nx) xb_add(&bar[XB_TOPGEN], 1u);
            else XB_SPIN(xb_ld(&bar[XB_TOPGEN]) == tg, bar);
            __builtin_amdgcn_fence(__ATOMIC_ACQUIRE, "agent");
            xb_add(&bar[XB_XGEN(b.x)], 1u);
            asm volatile("s_waitcnt vmcnt(0)" ::: "memory");
        } else {
            XB_SPIN(xb_ld(&bar[XB_XGEN(b.x)]) == gen, bar);
            __builtin_amdgcn_fence(__ATOMIC_ACQUIRE, "agent");
            asm volatile("s_waitcnt vmcnt(0)" ::: "memory");
        }
    }
    __syncthreads();
}

#define GSYNC(phv) do { if ((phv) == CG_SYNC_PHASE) grid.sync(); else { XcdBarrier xb_; xb_.bar = (unsigned*)(((KAP)__builtin_amdgcn_kernarg_segment_ptr())->ws + WS_CTL) + CW_BAR; xb_.x = xbar.x; xb_.st = (volatile LAS unsigned*)s_ctl; xcd_barrier(xb_); } } while (0)
__global__ void __launch_bounds__(512, 2) mega_fwd(KArgs a_) {
    extern __shared__ __attribute__((aligned(16))) unsigned char lds_raw[];
    __shared__ __attribute__((aligned(16))) unsigned s_ctl[4];
    LAS uchar* lds = (LAS uchar*)lds_raw;
    const int G = gridDim.x;
    cg::grid_group grid = cg::this_grid();
    if (threadIdx.x == 0) { s_ctl[0] = 0u; s_ctl[1] = 0u; }
    __syncthreads();
    XcdBarrier xbar = xcd_barrier_post((unsigned*)(a_.ws + WS_CTL) + CW_BAR, (volatile LAS unsigned*)s_ctl);
    const int ph_lo = a_.ph_lo, ph_hi = a_.ph_hi;
#if EXTRA_SYNCS
#pragma unroll 1
    for (int i = 0; i < EXTRA_SYNCS; ++i) GSYNC(1);
#endif
#pragma unroll 1
    for (int pass = 0; pass < (PRE_K > 0 ? 2 : NPASS); ++pass) {
    if (pass) GSYNC(1);
    const int ph_end = (PRE_K > 0 && pass == 0) ? PRE_K + 1 : ph_hi;
#pragma unroll 1
    for (int ph = (pass ? 1 : ph_lo); ph < ph_end; ++ph) {
        KAP a = (KAP)__builtin_amdgcn_kernarg_segment_ptr(); asm volatile("" : "+s"(a));
        unsigned* ctl = (unsigned*)(a->ws + WS_CTL);
        float* xs = a->out;
        bf16_t* AH = (bf16_t*)(a->ws + WS_AH); bf16_t* YIN = (bf16_t*)(a->ws + WS_YIN); bf16_t* AMIX = (bf16_t*)(a->ws + WS_AMIX); bf16_t* HFF = (bf16_t*)(a->ws + WS_HFF);
        if (ph > 0 && ((ph - 1) % 9 == 6 || ph == 10)) continue;
        int tid_ = threadIdx.x; asm volatile("" : "+v"(tid_));
        const int tid = tid_, lane = tid & 63, wave = __builtin_amdgcn_readfirstlane(tid >> 6);
        const int nrep = ((ph > 0 && (ph - 1) % 9 == REP_SP) || (ph == 0 && REP_SP == 100)) ? 2 : 1;
#pragma unroll 1
        for (int rep = 0; rep < nrep; ++rep) {
        if (rep) GSYNC(1);
        if (ph == 0) {
            p0_phase(a, lds, wave, lane, G, rep == 0);
        } else {
            const int l = (ph - 1) / 9, sp = (ph - 1) % 9;
            const float* modl = (const float*)(a->ws + WS_MOD) + (size_t)l * 3 * 6144;
            uchar* wt = a->ws + WS_WT + (size_t)l * WT_LAYER;
            float* rsb = (float*)(a->ws + WS_RS); const float* shwb = (const float*)(a->ws + WS_SHW);
            if (sp == 0) {
                norm_phase(a, a->in[I_XP], a->in[I_XS], a->in[I_N1], modl, 0, AH, rsb, wave, lane, G);
            } else if (sp == 1) {
                pg8::Gemm g{AH, (const bf16_t*)(wt + WT_IN), MT, NIN, DM}; pg8::StaticOrder S; S.init(MT, NIN, G, (int)blockIdx.x);
                pg8::EpiBf16<0> E{YIN, NIN, shwb + (size_t)(l * 2 + 0) * 3 * 4096, 0, 0, 1.f, rsb + (size_t)(l * 2 + 0) * MT * 16, 4096};
                pg8::gemm_phase<pg8::EpiBf16<0>, pg8::StaticOrder, true, true>(lds, g, S, E);
            } else if (sp >= 2 && sp <= 4) {
                unsigned* ctr = ctl + CW_Q + 64 * (l * 3 + (sp - 2) + 8 * rep + 16 * pass);
                const int nunits = sp == 2 ? 584 : sp == 3 ? 656 + NFILL(l) : 384;
                for (int ustat = (int)blockIdx.x;; ustat += G) {
                    int u;
                    if (sp == 2 && STATIC_Q && BAL_PMA && G == 256) {
                        const int bx = (int)blockIdx.x, k_ = (ustat - bx) / G;
                        if (k_ >= 4) break;
                        if (bx < 192) u = k_ == 0 ? 392 + bx : k_ == 1 ? bx : -1;
                        else u = k_ < 3 ? 200 + (bx - 192) * 3 + k_ : (bx < 200 ? bx : -1);
                        if (u < 0) continue;
                    }
                    else if (sp != 3 && STATIC_Q) { u = ustat; }
                    else {
                        if (tid == 0) s_ctl[2] = atomicAdd(ctr, 1u);
                        __syncthreads();
                        u = (int)s_ctl[2];
                        __syncthreads();
                    }
                    if (u >= nunits) break;
                    int tq_ = tid; asm volatile("" : "+v"(tq_)); const int tidq = tq_;
                    if (sp == 2) {
                        if (u < 192) prep_unit(a, l, u, tidq, false);
                        else if (u < 200) cachecvt_unit(a, l, u - 192, tidq);
                        else if (u < 392) hgrn_local_unit(a, l, u - 200, lds, tidq);
                        else rgl_local_unit(a, l, u - 392, lds, tidq);
                    } else if (sp == 3) {
                        if (u < 16) { if (!DIS_HGRN) hgrn_chain_unit(a, l, true, u >> 3, (u >> 1) & 3, u & 1, tidq); }
                        else if (u < 144) { const int i = u - 16; if (!DIS_ATTN) attn_unit(a, l, true, i >> 6, (i >> 4) & 3, i & 15, lds, tidq); }
                        else if (u < 400) { const int i = u - 144; if (!DIS_HGRN) hgrn_chain_unit(a, l, false, i >> 3, (i >> 1) & 3, i & 1, tidq); }
                        else if (u < 656) { const int i = u - 400; if (!DIS_ATTN) attn_unit(a, l, false, i >> 3, (i >> 1) & 3, i & 1, lds, tidq); }
                        else { const int it = (u - 656) * 8 + (tidq >> 6) + FILL_FIRST(l); if (it < FILL_END(l)) p0_item(a, it / I_L, it % I_L, (LAS float*)(lds + (tidq >> 6) * 16384), tidq & 63); __syncthreads(); }
                    } else {
                        if (u < 192) { if (!DIS_FIX) rgl_fixup_unit(a, l, u, tidq); }
                        else { if (!DIS_HGRN) hgrn_inter_unit(a, l, u - 192, lds, tidq); }
                    }
                }
            } else if (sp == 5) {
                pg8::Gemm g{AMIX, (const bf16_t*)(wt + WT_OUT), MT, DM, DM}; pg8::StaticOrder S; S.init(MT, DM, G, (int)blockIdx.x);
                pg8::EpiResGate E{l == 0 ? a->in[I_XP] : xs, l == 0 ? a->in[I_XS] - (size_t)MP * DM : xs, rep ? (float*)(a->ws + WS_HFF) : xs, modl, 2 * 1024,
                                  a->in[I_N2] + l * DM, modl + 4 * 1024, AH, rsb + (size_t)(l * 2 + 1) * MT * 16, X1_BF16 ? (bf16_t*)(a->ws + WS_HL) : nullptr, nullptr};
                pg8::gemm_phase<pg8::EpiResGate, pg8::StaticOrder, true, true>(lds, g, S, E);
                {
                    const int nbusy = 192, bx = (int)blockIdx.x;
                    const bool spare = G > nbusy; const int wv = spare ? (bx - nbusy) * 8 + wave : bx * 8 + wave, nwv = spare ? (G - nbusy) * 8 : G * 8;
                    if (!spare || bx >= nbusy) shw_rows(a, l, 1, wv, nwv, lane);
                }
            } else if (sp == 7) {
                pg8::Gemm g{AH, (const bf16_t*)(wt + WT_1), MT, DFF, DM}; pg8::StaticOrder S; S.init(MT, DFF, G, (int)blockIdx.x);
                pg8::EpiBf16<2> E{HFF, DFF, shwb + (size_t)(l * 2 + 1) * 3 * 4096, 0, 0, 1.f, rsb + (size_t)(l * 2 + 1) * MT * 16, 4096};
                pg8::gemm_phase<pg8::EpiBf16<2>, pg8::StaticOrder, true, true>(lds, g, S, E);
            } else if (sp == 8) {
                pg8::Gemm g{HFF, (const bf16_t*)(wt + WT_2), MT, DM, DFF}; pg8::StaticOrder S; S.init(MT, DM, G, (int)blockIdx.x);
                const bool last = (l == 1);
                pg8::EpiResGate E{xs, xs, xs, modl, 5 * 1024,
                                  last ? nullptr : a->in[I_N1] + (l + 1) * DM, modl + 3 * 6144 + 1 * 1024, AH, rsb + (size_t)((l + 1) * 2 + 0) * MT * 16, nullptr, X1_BF16 ? (const bf16_t*)(a->ws + WS_HL) : nullptr};
                pg8::gemm_phase<pg8::EpiResGate, pg8::StaticOrder, true, true>(lds, g, S, E);
                if (!last) {
                    const int nbusy = 192, bx = (int)blockIdx.x;
                    const bool spare = G > nbusy; const int wv = spare ? (bx - nbusy) * 8 + wave : bx * 8 + wave, nwv = spare ? (G - nbusy) * 8 : G * 8;
                    if (!spare || bx >= nbusy) shw_rows(a, l + 1, 0, wv, nwv, lane);
                }
            }
        }
        }
        if (ph + 1 < ph_end) GSYNC(ph);
    }
    }
}

extern "C" void kernel_launch(void* const* d_in, const int* in_sizes, int n_in, void* d_out, int out_size, void* d_ws, size_t ws_size, hipStream_t stream) {
    static int grid = 0;
    if (grid == 0) {
        if (n_in != 26 || ws_size < WS_END) { fprintf(stderr, "kernel_launch: unexpected n_in %d / ws %zu\n", n_in, ws_size); grid = -1; return; }
        int dev = 0, cus = 0, per_cu = 0;
        hipGetDevice(&dev);
        hipDeviceGetAttribute(&cus, hipDeviceAttributeMultiprocessorCount, dev);
        if (hipFuncSetAttribute((const void*)mega_fwd, hipFuncAttributeMaxDynamicSharedMemorySize, LDS_BYTES) != hipSuccess) { fprintf(stderr, "kernel_launch: hipFuncSetAttribute failed\n"); grid = -1; return; }
        hipOccupancyMaxActiveBlocksPerMultiprocessor(&per_cu, (const void*)mega_fwd, 512, LDS_BYTES);
        if (per_cu < 1) { fprintf(stderr, "kernel_launch: occupancy query says %d blocks per CU\n", per_cu); per_cu = 1; }
        (void)hipGetLastError();
        grid = cus * per_cu;
        if (grid > 256) grid = 256;
    }
    if (grid < 0) return;
    hipMemsetAsync((char*)d_ws + WS_CTL, 0, CTL_BYTES, stream);
    KArgs a{};
    for (int i = 0; i < 26; ++i) a.in[i] = (const float*)d_in[i];
    a.out = (float*)d_out; a.ws = (uchar*)d_ws;
#if MK_COOP
    a.ph_lo = 0; a.ph_hi = NPHASE;
    void* args[] = {&a};
    hipError_t e = hipLaunchCooperativeKernel((const void*)mega_fwd, dim3(grid), dim3(512), args, LDS_BYTES, stream);
    if (e != hipSuccess) fprintf(stderr, "cooperative launch failed: %s (grid %d)\n", hipGetErrorString(e), grid);
#else
    for (int ph = 0; ph < NPHASE; ++ph) {
        a.ph_lo = ph; a.ph_hi = ph + 1;
        hipLaunchKernelGGL(mega_fwd, dim3(grid), dim3(512), LDS_BYTES, stream, a);
    }
#endif
}
```
